# Optimizing an MI355X kernel written in HIP

```python
import jax, jax.numpy as jnp
from jax import lax
import numpy as np

D_MODEL = 1024
BATCH = 8
SEQ = 2048
DEPTH = 2

HEAD_DIM = D_MODEL // 8
DILATED_CONFIGS = ((128, 1), (512, 4), (2048, 16))
N_GROUPS = len(DILATED_CONFIGS)
N_SLOT_HEADS = 4
N_ATTN_HEADS = N_GROUPS * N_SLOT_HEADS
QKV_WIDTH = 3 * N_ATTN_HEADS * HEAD_DIM
ATTN_WIDTH = N_SLOT_HEADS * HEAD_DIM
N_MEM = 256
N_MEM_HEADS = 4
MEM_WIDTH = N_MEM_HEADS * HEAD_DIM
N_FOURIER_GROUPS = 4
FOURIER_GROUP_DIM = HEAD_DIM
FOURIER_WIDTH = N_FOURIER_GROUPS * FOURIER_GROUP_DIM
MIX_WIDTH = ATTN_WIDTH + MEM_WIDTH
D_FF = ((8 * D_MODEL // 3 + 255) // 256) * 256
N_EXPERTS = 8
TOP_K = 2
D_FF_EXPERT = 7 * D_MODEL // 2
ALPHA = (2.0 * DEPTH) ** 0.25
BETA = (8.0 * DEPTH) ** -0.25
LN_EPS = 1e-5
NEG_INF = -1e30
N_EVEN = (DEPTH + 1) // 2
N_ODD = DEPTH // 2

kernel_name = "hybrid_dilated_fourier_memory_moe_encoder"


def _layer_norm(x, g, b=None):
    xf = x.astype(jnp.float32)
    xc = xf - jnp.mean(xf, axis=-1, keepdims=True)
    var = jnp.mean(xc * xc, axis=-1, keepdims=True)
    y = xc * lax.rsqrt(var + LN_EPS) * g
    if b is not None:
        y = y + b
    return y.astype(x.dtype)


def _alibi_slopes():
    exps = np.arange(1, N_ATTN_HEADS + 1, dtype=np.float32) * np.float32(8.0 / N_ATTN_HEADS)
    return jnp.asarray(np.exp2(-exps).astype(np.float32))


def _dilated_group_attention(q, k, v, dilation, n_side, slopes):
    B, H, S, hd = q.shape
    L = S // dilation
    nb = -(-L // n_side)
    Lp = nb * n_side

    def classes(t):
        return t.reshape(B, H, L, dilation, hd).transpose(0, 1, 3, 2, 4)

    pad4 = ((0, 0), (0, 0), (0, 0))
    qb = jnp.pad(classes(q), pad4 + ((0, Lp - L), (0, 0))).reshape(B, H, dilation, nb, n_side, hd)

    def windows(t):
        tp = jnp.pad(classes(t), pad4 + ((n_side, Lp - L + n_side), (0, 0)))
        tp = tp.reshape(B, H, dilation, nb + 2, n_side, hd)
        return jnp.concatenate([tp[:, :, :, :-2], tp[:, :, :, 1:-1], tp[:, :, :, 2:]], axis=4)

    kw, vw = windows(k), windows(v)
    qi = jnp.arange(n_side)
    kj = jnp.arange(3 * n_side)
    blk = jnp.arange(nb)
    delta = kj[None, :] - n_side - qi[:, None]
    key_idx = blk[:, None] * n_side - n_side + kj[None, :]
    valid = (jnp.abs(delta) <= n_side)[None] & ((key_idx >= 0) & (key_idx < L))[:, None, :]
    dist = (jnp.abs(delta) * dilation).astype(jnp.float32)
    bias = -slopes.astype(jnp.float32)[:, None, None] * dist

    s = jnp.einsum('bhrnqd,bhrnkd->bhrnqk', qb, kw).astype(jnp.float32) * (hd ** -0.5)
    s = s + bias[None, :, None, None]
    s = jnp.where(valid[None, None, None], s, NEG_INF)
    m = jnp.max(s, axis=-1, keepdims=True)
    p = jnp.exp(s - m)
    l = jnp.sum(p, axis=-1, keepdims=True)
    o = jnp.einsum('bhrnqk,bhrnkd->bhrnqd', p, vw.astype(jnp.float32)) / l
    lse = (m + jnp.log(l))[..., 0]
    o = o.reshape(B, H, dilation, Lp, hd)[:, :, :, :L].transpose(0, 1, 3, 2, 4).reshape(B, H, S, hd)
    lse = lse.reshape(B, H, dilation, Lp)[..., :L].transpose(0, 1, 3, 2).reshape(B, H, S)
    return o, lse


def _memory_attention(q_flat, mem, w_mem_kv):
    B, S, _ = q_flat.shape
    n_mem = mem.shape[1]
    q = q_flat.reshape(B, S, N_MEM_HEADS, HEAD_DIM)
    kv = (mem @ w_mem_kv).reshape(B, n_mem, 2, N_MEM_HEADS, HEAD_DIM)
    s = jnp.einsum('bshd,bmhd->bhsm', q, kv[:, :, 0]).astype(jnp.float32) * (HEAD_DIM ** -0.5)
    p = jax.nn.softmax(s, axis=-1)
    o = jnp.einsum('bhsm,bmhd->bshd', p, kv[:, :, 1].astype(jnp.float32))
    return o.reshape(B, S, MEM_WIDTH).astype(q_flat.dtype)


def _dilated_mixer(x, mem, w_in, w_mem_kv, w_out):
    B, S, _ = x.shape
    proj = x @ w_in
    qkv = proj[..., :QKV_WIDTH].reshape(B, S, 3, N_GROUPS, N_SLOT_HEADS, HEAD_DIM)
    qkv = qkv.transpose(2, 3, 0, 4, 1, 5)
    q_mem = proj[..., QKV_WIDTH:]
    slopes = _alibi_slopes().reshape(N_GROUPS, N_SLOT_HEADS)
    outs, lses = [], []
    for g, (window, dilation) in enumerate(DILATED_CONFIGS):
        o, lse = _dilated_group_attention(qkv[0, g], qkv[1, g], qkv[2, g], dilation,
                                          window // (2 * dilation), slopes[g])
        outs.append(o)
        lses.append(lse)
    weights = jax.nn.softmax(jnp.stack(lses), axis=0)
    attn = jnp.einsum('gbhs,gbhsd->bshd', weights, jnp.stack(outs))
    attn = attn.reshape(B, S, ATTN_WIDTH).astype(x.dtype)
    mix = jnp.concatenate([attn, _memory_attention(q_mem, mem, w_mem_kv)], axis=-1)
    return mix @ w_out


def _fourier_mixer(x, mem, w_in, fourier_g, w_mem_kv, w_out):
    B, S, _ = x.shape
    proj = x @ w_in
    u = proj[..., :FOURIER_WIDTH].reshape(B, S, N_FOURIER_GROUPS, FOURIER_GROUP_DIM)
    u = _layer_norm(u, fourier_g)
    f = jnp.fft.fft2(u.astype(jnp.float32), axes=(1, 3), norm='ortho').real
    f = f.reshape(B, S, FOURIER_WIDTH).astype(x.dtype)
    q_mem = proj[..., FOURIER_WIDTH:]
    mix = jnp.concatenate([f, _memory_attention(q_mem, mem, w_mem_kv)], axis=-1)
    return mix @ w_out


def _swiglu(h, w_gate, w_up, w_down):
    return (jax.nn.silu(h @ w_gate) * (h @ w_up)) @ w_down


def _moe_swiglu(h, router_w, router_b, w_gate, w_up, w_down):
    B, S, D = h.shape
    t = h.reshape(B * S, D)
    logits = (t @ router_w).astype(jnp.float32) + router_b.astype(jnp.float32)
    top_logits, top_idx = lax.top_k(logits, TOP_K)
    gates = jax.nn.softmax(top_logits, axis=-1)
    combine = jnp.einsum('tk,tke->te', gates,
                         jax.nn.one_hot(top_idx, N_EXPERTS, dtype=jnp.float32)).astype(h.dtype)
    y = jnp.zeros_like(t)
    for e in range(N_EXPERTS):
        y = y + combine[:, e:e + 1] * _swiglu(t, w_gate[e], w_up[e], w_down[e])
    return y.reshape(B, S, D)


def _normal(key, shape, fan_in, scale=1.0):
    return jax.random.normal(key, shape, jnp.float32) * (scale * fan_in ** -0.5)


def _gain(key, shape):
    return 1.0 + 0.05 * jax.random.normal(key, shape, jnp.float32)


def _bias(key, shape, scale=0.02):
    return scale * jax.random.normal(key, shape, jnp.float32)


def setup_inputs(seed: int = 0) -> dict:
    key = jax.random.key(seed)
    ks = iter(jax.random.split(key, 32))
    D = D_MODEL
    x = jax.random.normal(next(ks), (BATCH, SEQ, D), jnp.float32)
    mem = jax.random.normal(next(ks), (BATCH, N_MEM, D), jnp.float32)
    a_w_in = jnp.concatenate([
        _normal(next(ks), (N_EVEN, D, 2 * N_ATTN_HEADS * HEAD_DIM), D),
        _normal(next(ks), (N_EVEN, D, N_ATTN_HEADS * HEAD_DIM), D, BETA),
        _normal(next(ks), (N_EVEN, D, MEM_WIDTH), D),
    ], axis=-1)
    a_w_mem_kv = jnp.concatenate([
        _normal(next(ks), (N_EVEN, D, MEM_WIDTH), D),
        _normal(next(ks), (N_EVEN, D, MEM_WIDTH), D, BETA),
    ], axis=-1)
    a_w_out = _normal(next(ks), (N_EVEN, MIX_WIDTH, D), MIX_WIDTH, BETA)
    a_ln1_g = _gain(next(ks), (N_EVEN, D))
    a_ln1_b = _bias(next(ks), (N_EVEN, D))
    a_ffn_gate = _normal(next(ks), (N_EVEN, D, D_FF), D)
    a_ffn_up = _normal(next(ks), (N_EVEN, D, D_FF), D)
    a_ffn_down = _normal(next(ks), (N_EVEN, D_FF, D), D_FF, BETA)
    a_ln2_g = _gain(next(ks), (N_EVEN, D))
    a_ln2_b = _bias(next(ks), (N_EVEN, D))
    b_w_in = _normal(next(ks), (N_ODD, D, FOURIER_WIDTH + MEM_WIDTH), D)
    b_fourier_g = _gain(next(ks), (N_ODD, N_FOURIER_GROUPS, FOURIER_GROUP_DIM))
    b_w_mem_kv = jnp.concatenate([
        _normal(next(ks), (N_ODD, D, MEM_WIDTH), D),
        _normal(next(ks), (N_ODD, D, MEM_WIDTH), D, BETA),
    ], axis=-1)
    b_w_out = _normal(next(ks), (N_ODD, MIX_WIDTH, D), MIX_WIDTH, BETA)
    b_ln1_g = _gain(next(ks), (N_ODD, D))
    b_ln1_b = _bias(next(ks), (N_ODD, D))
    b_router_w = _normal(next(ks), (N_ODD, D, N_EXPERTS), D)
    b_router_b = _bias(next(ks), (N_ODD, N_EXPERTS), 0.01)
    b_moe_gate = _normal(next(ks), (N_ODD, N_EXPERTS, D, D_FF_EXPERT), D)
    b_moe_up = _normal(next(ks), (N_ODD, N_EXPERTS, D, D_FF_EXPERT), D)
    b_moe_down = _normal(next(ks), (N_ODD, N_EXPERTS, D_FF_EXPERT, D), D_FF_EXPERT, BETA)
    b_ln2_g = _gain(next(ks), (N_ODD, D))
    b_ln2_b = _bias(next(ks), (N_ODD, D))
    return {
        "x": x, "mem": mem,
        "a_w_in": a_w_in, "a_w_mem_kv": a_w_mem_kv, "a_w_out": a_w_out,
        "a_ln1_g": a_ln1_g, "a_ln1_b": a_ln1_b,
        "a_ffn_gate": a_ffn_gate, "a_ffn_up": a_ffn_up, "a_ffn_down": a_ffn_down,
        "a_ln2_g": a_ln2_g, "a_ln2_b": a_ln2_b,
        "b_w_in": b_w_in, "b_fourier_g": b_fourier_g, "b_w_mem_kv": b_w_mem_kv, "b_w_out": b_w_out,
        "b_ln1_g": b_ln1_g, "b_ln1_b": b_ln1_b,
        "b_router_w": b_router_w, "b_router_b": b_router_b,
        "b_moe_gate": b_moe_gate, "b_moe_up": b_moe_up, "b_moe_down": b_moe_down,
        "b_ln2_g": b_ln2_g, "b_ln2_b": b_ln2_b,
    }


def reference(x, mem, a_w_in, a_w_mem_kv, a_w_out, a_ln1_g, a_ln1_b, a_ffn_gate, a_ffn_up,
              a_ffn_down, a_ln2_g, a_ln2_b, b_w_in, b_fourier_g, b_w_mem_kv, b_w_out, b_ln1_g,
              b_ln1_b, b_router_w, b_router_b, b_moe_gate, b_moe_up, b_moe_down, b_ln2_g, b_ln2_b):
    for i in range(DEPTH):
        j = i // 2
        if i % 2 == 0:
            y = _dilated_mixer(x, mem, a_w_in[j], a_w_mem_kv[j], a_w_out[j])
            x = _layer_norm(ALPHA * x + y, a_ln1_g[j], a_ln1_b[j])
            y = _swiglu(x, a_ffn_gate[j], a_ffn_up[j], a_ffn_down[j])
            x = _layer_norm(ALPHA * x + y, a_ln2_g[j], a_ln2_b[j])
        else:
            y = _fourier_mixer(x, mem, b_w_in[j], b_fourier_g[j], b_w_mem_kv[j], b_w_out[j])
            x = _layer_norm(ALPHA * x + y, b_ln1_g[j], b_ln1_b[j])
            y = _moe_swiglu(x, b_router_w[j], b_router_b[j], b_moe_gate[j], b_moe_up[j], b_moe_down[j])
            x = _layer_norm(ALPHA * x + y, b_ln2_g[j], b_ln2_b[j])
    return x
```

```cpp
#include <hip/hip_runtime.h>
#include <cstdio>
#include <cstdint>

constexpr int D = 1024, BATCH = 8, SEQ = 2048, T = BATCH * SEQ;
constexpr int HD = 128, NH = 12, QKVW = 4608, PROJA = 5120, NMEM = 256;
constexpr int DFF = 2816, NE = 8, DFE = 3584;
constexpr float ALPHA = 1.4142135623730951f;
constexpr float LN_EPS = 1e-5f;
constexpr float SCALE = 0.08838834764831845f;

__device__ __forceinline__ float wave_sum(float v) {
#pragma unroll
    for (int o = 1; o < 64; o <<= 1) v += __shfl_xor(v, o);
    return v;
}
__device__ __forceinline__ float wave_max(float v) {
#pragma unroll
    for (int o = 1; o < 64; o <<= 1) v = fmaxf(v, __shfl_xor(v, o));
    return v;
}

struct GArgs {
    const float* A; long lda; long sA; const int* aidx;
    const float* W; const float* W2; long ldw; long sW;
    float* C; long ldc; long sC;
    const float* R; long ldr; long sR; float alpha;
    const int* cnt; const int* cidx; const float* gate;
    int K; int pad;
};
template <int MODE>
__global__ __launch_bounds__(256) void k_gemm(GArgs g) {
    __shared__ float As[16][128 + 4];
    __shared__ float Ws[16][128 + 4];
    __shared__ float Ws2[MODE == 1 ? 16 : 1][128 + 4];
    const int tid = threadIdx.x, tx = tid & 15, ty = tid >> 4;
    const int z = blockIdx.z;
    const int m0 = blockIdx.y * 128, n0 = blockIdx.x * 128;
    int mlim = 1 << 30;
    if (g.cnt) { mlim = g.cnt[0]; if (m0 >= mlim) return; }
    const float* A = g.A + (long)z * g.sA;
    const float* W = g.W + (long)z * g.sW;
    const float* W2 = MODE == 1 ? g.W2 + (long)z * g.sW : nullptr;
    float acc[8][8], acc2[MODE == 1 ? 8 : 1][8];
#pragma unroll
    for (int i = 0; i < 8; ++i)
#pragma unroll
        for (int j = 0; j < 8; ++j) { acc[i][j] = 0.f; if (MODE == 1) acc2[i][j] = 0.f; }
    const int ar = tid >> 1, ak = (tid & 1) * 8;
    long arow = m0 + ar; bool avalid = arow < mlim;
    if (g.aidx) arow = avalid ? g.aidx[arow] : 0;
    const float* ap = A + arow * g.lda + ak;
    const int wk = tid >> 4, wn = (tid & 15) * 8;
    for (int k0 = 0; k0 < g.K; k0 += 16) {
        float4 a0 = avalid ? *(const float4*)(ap + k0) : make_float4(0, 0, 0, 0);
        float4 a1 = avalid ? *(const float4*)(ap + k0 + 4) : make_float4(0, 0, 0, 0);
        const float* wp = W + (long)(k0 + wk) * g.ldw + n0 + wn;
        float4 w0 = *(const float4*)wp, w1 = *(const float4*)(wp + 4);
        float4 v0, v1;
        if (MODE == 1) { const float* wp2 = W2 + (long)(k0 + wk) * g.ldw + n0 + wn; v0 = *(const float4*)wp2; v1 = *(const float4*)(wp2 + 4); }
        __syncthreads();
        As[ak + 0][ar] = a0.x; As[ak + 1][ar] = a0.y; As[ak + 2][ar] = a0.z; As[ak + 3][ar] = a0.w;
        As[ak + 4][ar] = a1.x; As[ak + 5][ar] = a1.y; As[ak + 6][ar] = a1.z; As[ak + 7][ar] = a1.w;
        *(float4*)&Ws[wk][wn] = w0; *(float4*)&Ws[wk][wn + 4] = w1;
        if (MODE == 1) { *(float4*)&Ws2[wk][wn] = v0; *(float4*)&Ws2[wk][wn + 4] = v1; }
        __syncthreads();
#pragma unroll
        for (int kk = 0; kk < 16; ++kk) {
            float a[8], b[8], b2[8];
#pragma unroll
            for (int i = 0; i < 8; ++i) a[i] = As[kk][ty * 8 + i];
#pragma unroll
            for (int j = 0; j < 8; ++j) { b[j] = Ws[kk][tx * 8 + j]; if (MODE == 1) b2[j] = Ws2[kk][tx * 8 + j]; }
#pragma unroll
            for (int i = 0; i < 8; ++i)
#pragma unroll
                for (int j = 0; j < 8; ++j) { acc[i][j] = fmaf(a[i], b[j], acc[i][j]); if (MODE == 1) acc2[i][j] = fmaf(a[i], b2[j], acc2[i][j]); }
        }
    }
    float* C = g.C + (long)z * g.sC;
#pragma unroll
    for (int i = 0; i < 8; ++i) {
        const long m = m0 + ty * 8 + i;
        if (m >= mlim) continue;
        if (MODE == 2) {
            const long orow = g.cidx[m]; const float gt = g.gate[m];
            float* cp = C + orow * g.ldc + n0 + tx * 8;
#pragma unroll
            for (int j = 0; j < 8; ++j) cp[j] += gt * acc[i][j];
        } else {
            float* cp = C + m * g.ldc + n0 + tx * 8;
#pragma unroll
            for (int j = 0; j < 8; ++j) {
                float v = acc[i][j];
                if (MODE == 1) { const float gg = v; v = gg / (1.f + __expf(-gg)) * acc2[i][j]; }
                if (MODE == 0 && g.R) v += g.alpha * g.R[(long)z * g.sR + m * g.ldr + n0 + tx * 8 + j];
                cp[j] = v;
            }
        }
    }
}

__global__ __launch_bounds__(256) void k_ln(const float* in, const float* gam, const float* bet, float* out, float* z, int rows) {
    const int row = blockIdx.x * 4 + (threadIdx.x >> 6), lane = threadIdx.x & 63;
    if (row >= rows) return;
    const float* p = in + (long)row * D;
    float v[16]; float s = 0.f;
#pragma unroll
    for (int j = 0; j < 16; ++j) { v[j] = p[lane + 64 * j]; s += v[j]; }
    const float mean = wave_sum(s) * (1.f / D);
    float q = 0.f;
#pragma unroll
    for (int j = 0; j < 16; ++j) { v[j] -= mean; q += v[j] * v[j]; }
    const float rstd = rsqrtf(wave_sum(q) * (1.f / D) + LN_EPS);
#pragma unroll
    for (int j = 0; j < 16; ++j) { const int c = lane + 64 * j; const float o = v[j] * rstd * gam[c] + bet[c]; out[(long)row * D + c] = o; if (z) z[(long)row * D + c] = ALPHA * o; }
}

__global__ __launch_bounds__(256) void k_dilated(const float* proj, float* mix) {
    const int w = blockIdx.x * 4 + (threadIdx.x >> 6), lane = threadIdx.x & 63;
    if (w >= T * 4) return;
    const int h = w & 3, tok = w >> 2, b = tok / SEQ, t = tok % SEQ;
    float og[3][2]; float lse[3];
#pragma unroll
    for (int g = 0; g < 3; ++g) {
        const int dil = g == 0 ? 1 : (g == 1 ? 4 : 16);
        const int hh = g * 4 + h;
        const float slope = exp2f(-(float)(hh + 1) * (8.0f / 12.0f));
        const float* q = proj + (long)tok * PROJA + (0 * 12 + hh) * HD;
        const float q0 = q[lane], q1 = q[lane + 64];
        float sc_mine[3] = {-1e30f, -1e30f, -1e30f};
#pragma unroll
        for (int r = 0; r < 3; ++r) {
            const int cntj = r == 2 ? 1 : 64;
            for (int i = 0; i < cntj; ++i) {
                const int jj = r == 0 ? i - 64 : (r == 1 ? i : 64);
                const int kpos = t + jj * dil;
                if (kpos < 0 || kpos >= SEQ) continue;
                const float* k = proj + ((long)b * SEQ + kpos) * PROJA + (1 * 12 + hh) * HD;
                float d = q0 * k[lane] + q1 * k[lane + 64];
                d = wave_sum(d);
                const float sc = d * SCALE - slope * (float)(abs(jj) * dil);
                if (lane == i) sc_mine[r] = sc;
            }
        }
        float m = fmaxf(fmaxf(sc_mine[0], sc_mine[1]), sc_mine[2]);
        m = wave_max(m);
        float p[3]; float l = 0.f;
#pragma unroll
        for (int r = 0; r < 3; ++r) { p[r] = sc_mine[r] > -1e29f ? __expf(sc_mine[r] - m) : 0.f; l += p[r]; }
        l = wave_sum(l);
        float o0 = 0.f, o1 = 0.f;
#pragma unroll
        for (int r = 0; r < 3; ++r) {
            const int cntj = r == 2 ? 1 : 64;
            for (int i = 0; i < cntj; ++i) {
                const int jj = r == 0 ? i - 64 : (r == 1 ? i : 64);
                const int kpos = t + jj * dil;
                if (kpos < 0 || kpos >= SEQ) continue;
                const float pj = __shfl(p[r], i);
                const float* v = proj + ((long)b * SEQ + kpos) * PROJA + (2 * 12 + hh) * HD;
                o0 += pj * v[lane]; o1 += pj * v[lane + 64];
            }
        }
        og[g][0] = o0 / l; og[g][1] = o1 / l; lse[g] = m + logf(l);
    }
    const float M = fmaxf(fmaxf(lse[0], lse[1]), lse[2]);
    const float w0 = __expf(lse[0] - M), w1 = __expf(lse[1] - M), w2 = __expf(lse[2] - M), ws = 1.f / (w0 + w1 + w2);
    float* o = mix + (long)tok * D + h * HD;
    o[lane] = (w0 * og[0][0] + w1 * og[1][0] + w2 * og[2][0]) * ws;
    o[lane + 64] = (w0 * og[0][1] + w1 * og[1][1] + w2 * og[2][1]) * ws;
}

__global__ __launch_bounds__(256) void k_memattn(const float* qbase, int ldq, const float* kv, float* mix) {
    const int w = blockIdx.x * 4 + (threadIdx.x >> 6), lane = threadIdx.x & 63;
    if (w >= T * 4) return;
    const int h = w & 3, tok = w >> 2, b = tok / SEQ;
    const float* q = qbase + (long)tok * ldq + h * HD;
    const float q0 = q[lane], q1 = q[lane + 64];
    float sc[4];
#pragma unroll
    for (int r = 0; r < 4; ++r) {
        sc[r] = 0.f;
        for (int i = 0; i < 64; ++i) {
            const float* k = kv + ((long)b * NMEM + r * 64 + i) * 1024 + h * HD;
            const float d = wave_sum(q0 * k[lane] + q1 * k[lane + 64]) * SCALE;
            if (i == lane) sc[r] = d;
        }
    }
    float mx = wave_max(fmaxf(fmaxf(sc[0], sc[1]), fmaxf(sc[2], sc[3])));
    float p[4], l = 0.f;
#pragma unroll
    for (int r = 0; r < 4; ++r) { p[r] = __expf(sc[r] - mx); l += p[r]; }
    l = wave_sum(l);
    float o0 = 0.f, o1 = 0.f;
#pragma unroll
    for (int r = 0; r < 4; ++r) {
        for (int i = 0; i < 64; ++i) {
            const float pj = __shfl(p[r], i);
            const float* v = kv + ((long)b * NMEM + r * 64 + i) * 1024 + 512 + h * HD;
            o0 += pj * v[lane]; o1 += pj * v[lane + 64];
        }
    }
    float* o = mix + (long)tok * D + 512 + h * HD;
    o[lane] = o0 / l; o[lane + 64] = o1 / l;
}

__global__ __launch_bounds__(256) void k_groupln(const float* proj1, const float* fg, float* u) {
    const int tok = blockIdx.x * 4 + (threadIdx.x >> 6), lane = threadIdx.x & 63;
    if (tok >= T) return;
    const float* p = proj1 + (long)tok * D + lane * 8;
    float v[8], s = 0.f;
#pragma unroll
    for (int j = 0; j < 8; ++j) { v[j] = p[j]; s += v[j]; }
#pragma unroll
    for (int o = 1; o < 16; o <<= 1) s += __shfl_xor(s, o);
    const float mean = s * (1.f / 128.f); float q = 0.f;
#pragma unroll
    for (int j = 0; j < 8; ++j) { v[j] -= mean; q += v[j] * v[j]; }
#pragma unroll
    for (int o = 1; o < 16; o <<= 1) q += __shfl_xor(q, o);
    const float rstd = rsqrtf(q * (1.f / 128.f) + LN_EPS);
#pragma unroll
    for (int j = 0; j < 8; ++j) u[(long)tok * 512 + lane * 8 + j] = v[j] * rstd * fg[lane * 8 + j];
}
__global__ void k_dftmats(float* Tc, float* Ts, float* Cs, float* Ssn) {
    const long i = (long)blockIdx.x * blockDim.x + threadIdx.x;
    if (i < 128 * 128) { const int c = i / 128, l = i % 128; const int idx = (c * l) & 127; Tc[i] = cospif(idx / 64.f); Ts[i] = sinpif(idx / 64.f); }
    if (i < (long)SEQ * SEQ) { const int k = i / SEQ, s = i % SEQ; const int idx = (k * s) & 2047; Cs[i] = cospif(idx / 1024.f) * (1.f / 512.f); Ssn[i] = -sinpif(idx / 1024.f) * (1.f / 512.f); }
}

__global__ __launch_bounds__(256) void k_router(const float* x3, const float* rw, const float* rb, int* cnt, int* tok_of_slot, float* gate_of_slot) {
    const int tok = blockIdx.x * 4 + (threadIdx.x >> 6), lane = threadIdx.x & 63;
    if (tok >= T) return;
    float lg[8];
#pragma unroll
    for (int e = 0; e < 8; ++e) lg[e] = 0.f;
    for (int j = 0; j < 16; ++j) { const int c = lane + 64 * j; const float xv = x3[(long)tok * D + c];
#pragma unroll
        for (int e = 0; e < 8; ++e) lg[e] += xv * rw[c * 8 + e]; }
#pragma unroll
    for (int e = 0; e < 8; ++e) lg[e] = wave_sum(lg[e]) + rb[e];
    int e1 = 0; float v1 = lg[0];
#pragma unroll
    for (int e = 1; e < 8; ++e) if (lg[e] > v1) { v1 = lg[e]; e1 = e; }
    int e2 = -1; float v2 = -3.4e38f;
#pragma unroll
    for (int e = 0; e < 8; ++e) if (e != e1 && lg[e] > v2) { v2 = lg[e]; e2 = e; }
    const float p2 = __expf(v2 - v1), g1 = 1.f / (1.f + p2), g2 = p2 / (1.f + p2);
    if (lane == 0) {
        const int p1 = atomicAdd(&cnt[e1], 1); tok_of_slot[e1 * T + p1] = tok; gate_of_slot[e1 * T + p1] = g1;
        const int pp = atomicAdd(&cnt[e2], 1); tok_of_slot[e2 * T + pp] = tok; gate_of_slot[e2 * T + pp] = g2;
    }
}

template <int MODE> static void gemm(hipStream_t st, GArgs g, int M, int N, int batch) {
    hipLaunchKernelGGL((k_gemm<MODE>), dim3(N / 128, M / 128, batch), dim3(256), 0, st, g);
}
static GArgs mk(const float* A, long lda, const float* W, long ldw, float* C, long ldc, int K) {
    GArgs g{}; g.A = A; g.lda = lda; g.W = W; g.ldw = ldw; g.C = C; g.ldc = ldc; g.K = K; g.alpha = 0.f; return g;
}

extern "C" void kernel_launch(void* const* d_in, const int* in_sizes, int n_in, void* d_out, int out_size, void* d_ws, size_t ws_size, hipStream_t stream) {
    const float* x = (const float*)d_in[0]; const float* mem = (const float*)d_in[1];
    const float* a_w_in = (const float*)d_in[2]; const float* a_w_kv = (const float*)d_in[3]; const float* a_w_out = (const float*)d_in[4];
    const float* a_ln1_g = (const float*)d_in[5]; const float* a_ln1_b = (const float*)d_in[6];
    const float* a_gate = (const float*)d_in[7]; const float* a_up = (const float*)d_in[8]; const float* a_down = (const float*)d_in[9];
    const float* a_ln2_g = (const float*)d_in[10]; const float* a_ln2_b = (const float*)d_in[11];
    const float* b_w_in = (const float*)d_in[12]; const float* b_fg = (const float*)d_in[13]; const float* b_w_kv = (const float*)d_in[14]; const float* b_w_out = (const float*)d_in[15];
    const float* b_ln1_g = (const float*)d_in[16]; const float* b_ln1_b = (const float*)d_in[17];
    const float* b_rw = (const float*)d_in[18]; const float* b_rb = (const float*)d_in[19];
    const float* b_gate = (const float*)d_in[20]; const float* b_up = (const float*)d_in[21]; const float* b_down = (const float*)d_in[22];
    const float* b_ln2_g = (const float*)d_in[23]; const float* b_ln2_b = (const float*)d_in[24];
    float* out = (float*)d_out;
    if (n_in != 25 || out_size != T * D) { fprintf(stderr, "kernel_launch: unexpected shapes\n"); return; }
    const size_t MiB = 1u << 20;
    if (ws_size < 470 * MiB) { fprintf(stderr, "kernel_launch: ws too small %zu\n", ws_size); return; }
    char* ws = (char*)d_ws;
    int* cnt = (int*)ws;
    float* kv_a = (float*)(ws + 1 * MiB);
    float* kv_b = (float*)(ws + 9 * MiB);
    float* proj0 = (float*)(ws + 17 * MiB);
    float* mix = (float*)(ws + 337 * MiB);
    float* x1 = (float*)(ws + 401 * MiB);
    float* hbuf = (float*)(ws + 17 * MiB);
    float* x2 = (float*)(ws + 193 * MiB);
    float* proj1 = (float*)(ws + 257 * MiB);
    float* u = (float*)(ws + 17 * MiB);
    float* AC = (float*)(ws + 49 * MiB);
    float* AS = (float*)(ws + 81 * MiB);
    float* Cs = (float*)(ws + 113 * MiB);
    float* Ssn = (float*)(ws + 129 * MiB);
    float* Tc = (float*)(ws + 145 * MiB);
    float* Ts = (float*)(ws + 146 * MiB);
    float* z = (float*)(ws + 257 * MiB);
    int* tok_of_slot = (int*)(ws + 321 * MiB);
    float* gate_of_slot = (float*)(ws + 322 * MiB);
    float* He = (float*)(ws + 17 * MiB);

    (void)hipMemsetAsync(cnt, 0, 4096, stream);
    { GArgs g = mk(x, D, a_w_in, PROJA, proj0, PROJA, D); gemm<0>(stream, g, T, PROJA, 1); }
    { GArgs g = mk(mem, D, a_w_kv, 1024, kv_a, 1024, D); gemm<0>(stream, g, BATCH * NMEM, 1024, 1); }
    { GArgs g = mk(mem, D, b_w_kv, 1024, kv_b, 1024, D); gemm<0>(stream, g, BATCH * NMEM, 1024, 1); }
    hipLaunchKernelGGL(k_dilated, dim3(T * 4 / 4), dim3(256), 0, stream, proj0, mix);
    hipLaunchKernelGGL(k_memattn, dim3(T * 4 / 4), dim3(256), 0, stream, proj0 + QKVW, PROJA, kv_a, mix);
    { GArgs g = mk(mix, D, a_w_out, D, out, D, D); g.R = x; g.ldr = D; g.alpha = ALPHA; gemm<0>(stream, g, T, D, 1); }
    hipLaunchKernelGGL(k_ln, dim3(T / 4), dim3(256), 0, stream, out, a_ln1_g, a_ln1_b, x1, (float*)nullptr, T);
    { GArgs g = mk(x1, D, a_gate, DFF, hbuf, DFF, D); g.W2 = a_up; gemm<1>(stream, g, T, DFF, 1); }
    { GArgs g = mk(hbuf, DFF, a_down, D, out, D, DFF); g.R = x1; g.ldr = D; g.alpha = ALPHA; gemm<0>(stream, g, T, D, 1); }
    hipLaunchKernelGGL(k_ln, dim3(T / 4), dim3(256), 0, stream, out, a_ln2_g, a_ln2_b, x2, (float*)nullptr, T);
    { GArgs g = mk(x2, D, b_w_in, D, proj1, D, D); gemm<0>(stream, g, T, D, 1); }
    hipLaunchKernelGGL(k_groupln, dim3(T / 4), dim3(256), 0, stream, proj1, b_fg, u);
    hipLaunchKernelGGL(k_dftmats, dim3((SEQ * SEQ + 255) / 256), dim3(256), 0, stream, Tc, Ts, Cs, Ssn);
    { GArgs g = mk(u, 512, Tc, 128, AC, 512, 128); g.sA = 128; g.sW = 0; g.sC = 128; gemm<0>(stream, g, T, 128, 4); }
    { GArgs g = mk(u, 512, Ts, 128, AS, 512, 128); g.sA = 128; g.sW = 0; g.sC = 128; gemm<0>(stream, g, T, 128, 4); }
    { GArgs g = mk(Cs, SEQ, AC, 512, mix, D, SEQ); g.sA = 0; g.sW = (long)SEQ * 512; g.sC = (long)SEQ * D; gemm<0>(stream, g, SEQ, 512, BATCH); }
    { GArgs g = mk(Ssn, SEQ, AS, 512, mix, D, SEQ); g.sA = 0; g.sW = (long)SEQ * 512; g.sC = (long)SEQ * D; g.R = mix; g.ldr = D; g.sR = (long)SEQ * D; g.alpha = 1.f; gemm<0>(stream, g, SEQ, 512, BATCH); }
    hipLaunchKernelGGL(k_memattn, dim3(T * 4 / 4), dim3(256), 0, stream, proj1 + 512, D, kv_b, mix);
    { GArgs g = mk(mix, D, b_w_out, D, out, D, D); g.R = x2; g.ldr = D; g.alpha = ALPHA; gemm<0>(stream, g, T, D, 1); }
    hipLaunchKernelGGL(k_ln, dim3(T / 4), dim3(256), 0, stream, out, b_ln1_g, b_ln1_b, out, z, T);
    hipLaunchKernelGGL(k_router, dim3(T / 4), dim3(256), 0, stream, out, b_rw, b_rb, cnt, tok_of_slot, gate_of_slot);
    for (int e = 0; e < NE; ++e) {
        { GArgs g = mk(out, D, b_gate + (long)e * D * DFE, DFE, He, DFE, D); g.W2 = b_up + (long)e * D * DFE; g.aidx = tok_of_slot + e * T; g.cnt = cnt + e; gemm<1>(stream, g, T, DFE, 1); }
        { GArgs g = mk(He, DFE, b_down + (long)e * DFE * D, D, z, D, DFE); g.cnt = cnt + e; g.cidx = tok_of_slot + e * T; g.gate = gate_of_slot + e * T; gemm<2>(stream, g, T, D, 1); }
    }
    hipLaunchKernelGGL(k_ln, dim3(T / 4), dim3(256), 0, stream, z, b_ln2_g, b_ln2_b, out, (float*)nullptr, T);
}
```

```cpp
#include <hip/hip_runtime.h>
#include <cstdio>
#include <cstdint>

constexpr int D = 1024, BATCH = 8, SEQ = 2048, T = BATCH * SEQ;
constexpr int HD = 128, QKVW = 4608, PROJA = 5120, NMEM = 256;
constexpr int DFF = 2816, NE = 8, DFE = 3584;
constexpr float ALPHA = 1.4142135623730951f;
constexpr float LN_EPS = 1e-5f;
constexpr float SCALE = 0.08838834764831845f;
constexpr float LOG2E = 1.4426950408889634f, LN2 = 0.6931471805599453f;

#define GAS __attribute__((address_space(1)))
#define LAS __attribute__((address_space(3)))
typedef unsigned short bf16;
typedef unsigned v4u __attribute__((ext_vector_type(4)));
typedef unsigned v2u __attribute__((ext_vector_type(2)));
typedef float f32x4 __attribute__((ext_vector_type(4)));
typedef float f32x2 __attribute__((ext_vector_type(2)));
typedef float f32x16 __attribute__((ext_vector_type(16)));
typedef short bf16x8 __attribute__((ext_vector_type(8)));
typedef short s16x4 __attribute__((ext_vector_type(4)));

__device__ __forceinline__ float wave_sum(float v) {
#pragma unroll
    for (int o = 1; o < 64; o <<= 1) v += __shfl_xor(v, o);
    return v;
}
__device__ __forceinline__ float wave_max(float v) {
#pragma unroll
    for (int o = 1; o < 64; o <<= 1) v = fmaxf(v, __shfl_xor(v, o));
    return v;
}
__device__ __forceinline__ unsigned cvt_pk_bf16(float lo, float hi) { unsigned r; asm volatile("v_cvt_pk_bf16_f32 %0, %1, %2" : "=v"(r) : "v"(lo), "v"(hi)); return r; }
__device__ __forceinline__ float bf2f(unsigned short b) { return __uint_as_float(((unsigned)b) << 16); }

namespace pg8 {
#define PG8_LAS __attribute__((address_space(3)))
constexpr int BM = 256, BK = 64, HALF = 128, HTB = HALF * BK * 2  , STAGE_BYTES = 8 * HTB, NXCD = 8, WGM = 8;
__host__ __device__ __forceinline__ int lds_byte(int r, int c) { const int st = (r >> 4) * 2 + (c >> 5), rr = r & 15, cc = c & 31, ob = rr * 64 + cc * 2; return st * 1024 + (ob ^ (((ob >> 9) & 1) << 5)); }
__host__ __device__ __forceinline__ void stage_rc(int b, int& R, int& C) { const int st = b / 1024, sb = b % 1024, swz = sb ^ (((sb >> 9) & 1) << 5); R = (st >> 1) * 16 + swz / 64; C = (st & 1) * 32 + (swz % 64) / 2; }
__host__ __device__ __forceinline__ int perm32(int rho) { const int n = rho >> 4, i = rho & 15; return 8 * (i >> 2) + 4 * n + (i & 3); }

struct Unit { const char* A; const char* B; char* C; int aux; };

__device__ __forceinline__ bool tile_order(int L, int nM, int nN, int& pm, int& pn) {
    const int nwg = nM * nN; if (L >= nwg) return false;
    int wgid = L; { const int q = nwg / NXCD, r = nwg % NXCD, xcd = wgid % NXCD, off = wgid / NXCD; wgid = (xcd < r ? xcd * (q + 1) : r * (q + 1) + (xcd - r) * q) + off; }
    const int nig = WGM * nN, gid = wgid / nig, fm = gid * WGM, gsz = (nM - fm) < WGM ? (nM - fm) : WGM;
    pm = fm + ((wgid % nig) % gsz); pn = (wgid % nig) / gsz; return true;
}
struct PlainOrder {
    const char* A; const char* B; char* C; int nM, nN, G, c; size_t aT, bT, cTm, cTn;
    __device__ void init(const void* A_, int lda, const void* B_, int ldb, void* C_, int ldc, int csz, int cw, int M, int N, int G_, int c_) {
        A = (const char*)A_; B = (const char*)B_; C = (char*)C_; nM = M / BM; nN = N / BM; G = G_; c = c_;
        aT = (size_t)BM * lda * 2; bT = (size_t)BM * ldb * 2; cTm = (size_t)BM * ldc * csz; cTn = (size_t)cw * csz; }
    __device__ __forceinline__ bool next(int i, Unit& u) const { int pm, pn; if (!tile_order(i * G + c, nM, nN, pm, pn)) return false;
        u.A = A + pm * aT; u.B = B + pn * bT; u.C = C + pm * cTm + pn * cTn; u.aux = 0; return true; }
    __device__ __forceinline__ void a_ready(const Unit&) const {}
    __device__ __forceinline__ void done(const Unit&) const {}
};

struct EpiBf16 {
    static constexpr bool PERM = true, AFTER_DRAIN = false;
    int ldc; int hs; float s;
    __device__ __forceinline__ void operator()(const f32x4 (&acc)[2][2][4][2], const Unit& u, int wr, int wc, int fr, int fq) const {
        bf16* base = (bf16*)u.C + (wr * 64 + fr) * (size_t)ldc + wc * 32 + 8 * fq;
#pragma unroll
        for (int ai = 0; ai < 2; ++ai)
#pragma unroll
            for (int m = 0; m < 4; ++m) { bf16* rowp = base + (size_t)ai * hs + (size_t)(m * 16) * ldc;
#pragma unroll
                for (int bj = 0; bj < 2; ++bj) { const f32x4 v0 = acc[ai][bj][m][0] * s, v1 = acc[ai][bj][m][1] * s;
                    v4u w; w.x = cvt_pk_bf16(v0[0], v0[1]); w.y = cvt_pk_bf16(v0[2], v0[3]); w.z = cvt_pk_bf16(v1[0], v1[1]); w.w = cvt_pk_bf16(v1[2], v1[3]);
                    *(v4u*)(rowp + bj * HALF) = w; } }
    }
};
struct EpiSwiGLU {
    static constexpr bool PERM = true, AFTER_DRAIN = false;
    int ldc;
    __device__ __forceinline__ void operator()(const f32x4 (&acc)[2][2][4][2], const Unit& u, int wr, int wc, int fr, int fq) const {
        bf16* base = (bf16*)u.C + (wr * 64 + fr) * (size_t)ldc + wc * 32 + 8 * fq;
#pragma unroll
        for (int ai = 0; ai < 2; ++ai)
#pragma unroll
            for (int m = 0; m < 4; ++m) { bf16* rowp = base + (size_t)(ai * HALF + m * 16) * ldc; float h[8];
#pragma unroll
                for (int n = 0; n < 2; ++n)
#pragma unroll
                    for (int j = 0; j < 4; ++j) { const float g = acc[ai][0][m][n][j], up = acc[ai][1][m][n][j];
                        h[n * 4 + j] = g * __builtin_amdgcn_rcpf(1.f + __builtin_amdgcn_exp2f(-g * LOG2E)) * up; }
                v4u w; w.x = cvt_pk_bf16(h[0], h[1]); w.y = cvt_pk_bf16(h[2], h[3]); w.z = cvt_pk_bf16(h[4], h[5]); w.w = cvt_pk_bf16(h[6], h[7]);
                *(v4u*)rowp = w; }
    }
};
struct EpiF32Res {
    static constexpr bool PERM = false, AFTER_DRAIN = false;
    int ldc; long rdelta; float alpha;
    __device__ __forceinline__ void operator()(const f32x4 (&acc)[2][2][4][2], const Unit& u, int wr, int wc, int fr, int fq) const {
        float* base = (float*)u.C + (wr * 64 + fr) * (size_t)ldc + wc * 32 + 4 * fq;
#pragma unroll
        for (int ai = 0; ai < 2; ++ai)
#pragma unroll
            for (int m = 0; m < 4; ++m) { float* rowp = base + (size_t)(ai * HALF + m * 16) * ldc;
#pragma unroll
                for (int bj = 0; bj < 2; ++bj)
#pragma unroll
                    for (int n = 0; n < 2; ++n) { float* p = rowp + bj * HALF + n * 16; f32x4 v = acc[ai][bj][m][n];
                        if (alpha != 0.f) { const f32x4 r = *(const f32x4*)((const char*)p + rdelta); v = v + r * alpha; }
                        *(f32x4*)p = v; } }
    }
};

template <class Epi, class Sched, bool ALIGN_EPI = false, bool SP2 = false>
__device__ __forceinline__ void gemm_phase(PG8_LAS unsigned char* lds, const int K, const int lda, const int ldb, const Sched& S, const Epi& E) {
    const int tid = threadIdx.x, wid = __builtin_amdgcn_readfirstlane(tid >> 6), lane = tid & 63, wr = wid >> 2, wc = wid & 3, fr = lane & 15, fq = lane >> 4;
    const int nt = K / BK;
    unsigned voffA[2], voffB[2];
#pragma unroll
    for (int i = 0; i < 2; ++i) { int R, C; stage_rc(tid * 16 + i * 8192, R, C); const int Rb = Epi::PERM ? ((R & ~31) + perm32(R & 31)) : R;
        voffA[i] = (unsigned)(R * lda + C) * 2u; voffB[i] = (unsigned)(Rb * ldb + C) * 2u; }
    const size_t kstep = (size_t)(BK * 2);
    const size_t hstepA = (size_t)HALF * lda * 2, hstepB = (size_t)HALF * ldb * 2;
    const unsigned ldsw = (unsigned)wid * 1024u;
    const int aoff = lds_byte(wr * 64 + fr, fq * 8), boff = lds_byte(wc * 32 + fr, fq * 8);
#define PG8_SA(b, h) (((b) * 2 + (h)) * HTB)
#define PG8_SB(b, h) ((4 + (b) * 2 + (h)) * HTB)
#define PG8_STAGE(bufoff, gbase, voff) do { _Pragma("unroll") for (int _i = 0; _i < 2; ++_i) \
        __builtin_amdgcn_global_load_lds((const unsigned*)((const char*)(gbase) + (voff)[_i]), (PG8_LAS unsigned*)(lds + (bufoff) + ldsw + _i * 8192), 16, 0, 0); } while (0)
#define PG8_LDA(dst, b, h) do { _Pragma("unroll") for (int m = 0; m < 4; ++m) _Pragma("unroll") for (int k = 0; k < 2; ++k) dst[m][k] = *(const PG8_LAS bf16x8*)(lds + PG8_SA(b, h) + aoff + m * 2048 + k * 1024); } while (0)
#define PG8_LDB(dst, b, h) do { _Pragma("unroll") for (int n = 0; n < 2; ++n) _Pragma("unroll") for (int k = 0; k < 2; ++k) dst[n][k] = *(const PG8_LAS bf16x8*)(lds + PG8_SB(b, h) + boff + n * 2048 + k * 1024); } while (0)
#define PG8_MMA(ai, bj, At, Bt) do { __builtin_amdgcn_s_setprio(1); _Pragma("unroll") for (int m = 0; m < 4; ++m) _Pragma("unroll") for (int n = 0; n < 2; ++n) _Pragma("unroll") for (int k = 0; k < 2; ++k) \
        acc[ai][bj][m][n] = __builtin_amdgcn_mfma_f32_16x16x32_bf16(Bt[n][k], At[m][k], acc[ai][bj][m][n], 0, 0, 0); __builtin_amdgcn_s_setprio(0); } while (0)
#define PG8_WAIT_V(n) asm volatile("s_waitcnt vmcnt(" #n ")" ::: "memory")
#define PG8_WAIT_L(n) asm volatile("s_waitcnt lgkmcnt(" #n ")" ::: "memory")
#define PG8_BAR __builtin_amdgcn_s_barrier()
#define PG8_SCHED __builtin_amdgcn_sched_barrier(0)
    Unit cur, nxt; int ui = 0;
    if (!S.next(0, cur)) return;
    f32x4 acc[2][2][4][2];
#pragma unroll
    for (int a = 0; a < 2; ++a)
#pragma unroll
        for (int b = 0; b < 2; ++b)
#pragma unroll
            for (int m = 0; m < 4; ++m)
#pragma unroll
                for (int n = 0; n < 2; ++n) acc[a][b][m][n] = (f32x4){0.f, 0.f, 0.f, 0.f};
    bf16x8 At[4][2], B0[2][2], B1[2][2];
    const char* cA = cur.A; const char* cB = cur.B;
    S.a_ready(cur);
    if constexpr (SP2) {
        PG8_STAGE(PG8_SB(0, 0), cB, voffB); PG8_STAGE(PG8_SB(0, 1), cB + hstepB, voffB); PG8_STAGE(PG8_SA(0, 0), cA, voffA); PG8_STAGE(PG8_SA(0, 1), cA + hstepA, voffA);
        if (wr == 1) PG8_BAR;
        PG8_WAIT_V(2); PG8_BAR;
        PG8_STAGE(PG8_SB(1, 0), cB + kstep, voffB); PG8_STAGE(PG8_SA(1, 0), cA + kstep, voffA); PG8_STAGE(PG8_SB(1, 1), cB + hstepB + kstep, voffB);
        PG8_WAIT_V(6); PG8_BAR;
    } else {
        PG8_STAGE(PG8_SB(0, 0), cB, voffB); PG8_STAGE(PG8_SA(0, 0), cA, voffA); PG8_STAGE(PG8_SB(0, 1), cB + hstepB, voffB); PG8_STAGE(PG8_SA(0, 1), cA + hstepA, voffA);
        if (wr == 1) PG8_BAR;
        PG8_WAIT_V(4); PG8_BAR;
        PG8_STAGE(PG8_SB(1, 0), cB + kstep, voffB); PG8_STAGE(PG8_SA(1, 0), cA + kstep, voffA); PG8_STAGE(PG8_SB(1, 1), cB + hstepB + kstep, voffB);
        PG8_WAIT_V(6); PG8_BAR;
    }
    for (;;) {
        const bool has_next = S.next(ui + 1, nxt);
        const char* nA = has_next ? nxt.A : cA; const char* nB = has_next ? nxt.B : cB;
#pragma unroll 1
        for (int t = 0; t < nt; t += 2) {
            const bool last = (t == nt - 2);
            const char* a1 = cA + (size_t)(t + 1) * kstep;
            const char* a2 = last ? nA : cA + (size_t)(t + 2) * kstep; const char* b2 = last ? nB : cB + (size_t)(t + 2) * kstep;
            const char* a3 = a2 + kstep; const char* b3 = b2 + kstep;
            if (last && has_next) S.a_ready(nxt);
            if constexpr (SP2) {
            PG8_LDB(B0, 0, 0); PG8_LDB(B1, 0, 1); PG8_SCHED; PG8_LDA(At, 0, 0); PG8_STAGE(PG8_SA(1, 1), a1 + hstepA, voffA);
            PG8_WAIT_V(8); PG8_WAIT_L(0); PG8_BAR; PG8_MMA(0, 0, At, B0); PG8_MMA(0, 1, At, B1); PG8_BAR; PG8_SCHED;
            PG8_LDA(At, 0, 1); PG8_STAGE(PG8_SB(0, 0), b2, voffB); PG8_STAGE(PG8_SB(0, 1), b2 + hstepB, voffB); PG8_STAGE(PG8_SA(0, 0), a2, voffA);
            PG8_WAIT_V(8); PG8_WAIT_L(0); PG8_BAR; PG8_MMA(1, 0, At, B0); PG8_MMA(1, 1, At, B1); PG8_BAR; PG8_SCHED;
            PG8_LDB(B0, 1, 0); PG8_LDB(B1, 1, 1); PG8_SCHED; PG8_LDA(At, 1, 0); PG8_STAGE(PG8_SA(0, 1), a2 + hstepA, voffA);
            PG8_WAIT_V(8); PG8_WAIT_L(0); PG8_BAR; PG8_MMA(0, 0, At, B0); PG8_MMA(0, 1, At, B1); PG8_BAR; PG8_SCHED;
            PG8_LDA(At, 1, 1); PG8_STAGE(PG8_SB(1, 0), b3, voffB); PG8_STAGE(PG8_SB(1, 1), b3 + hstepB, voffB); PG8_STAGE(PG8_SA(1, 0), a3, voffA);
            PG8_WAIT_V(8); PG8_WAIT_L(0); PG8_BAR; PG8_MMA(1, 0, At, B0); PG8_MMA(1, 1, At, B1); PG8_BAR; PG8_SCHED;
            } else {
            PG8_LDB(B0, 0, 0); PG8_SCHED; PG8_LDA(At, 0, 0); PG8_STAGE(PG8_SA(1, 1), a1 + hstepA, voffA);
            PG8_WAIT_L(8); PG8_BAR; PG8_WAIT_L(0); PG8_MMA(0, 0, At, B0); PG8_BAR; PG8_SCHED;
            PG8_LDB(B1, 0, 1); PG8_STAGE(PG8_SB(0, 0), b2, voffB);
            PG8_BAR; PG8_WAIT_L(0); PG8_MMA(0, 1, At, B1); PG8_BAR;
            PG8_LDA(At, 0, 1); PG8_STAGE(PG8_SA(0, 0), a2, voffA);
            PG8_BAR; PG8_WAIT_L(0); PG8_MMA(1, 0, At, B0); PG8_BAR; PG8_SCHED;
            PG8_STAGE(PG8_SB(0, 1), b2 + hstepB, voffB);
            PG8_WAIT_V(6); PG8_BAR; PG8_MMA(1, 1, At, B1); PG8_BAR;
            PG8_LDB(B0, 1, 0); PG8_SCHED; PG8_LDA(At, 1, 0); PG8_STAGE(PG8_SA(0, 1), a2 + hstepA, voffA);
            PG8_WAIT_L(8); PG8_BAR; PG8_WAIT_L(0); PG8_MMA(0, 0, At, B0); PG8_BAR; PG8_SCHED;
            PG8_LDB(B1, 1, 1); PG8_STAGE(PG8_SB(1, 0), b3, voffB);
            PG8_BAR; PG8_WAIT_L(0); PG8_MMA(0, 1, At, B1); PG8_BAR;
            PG8_LDA(At, 1, 1); PG8_STAGE(PG8_SA(1, 0), a3, voffA);
            PG8_BAR; PG8_WAIT_L(0); PG8_MMA(1, 0, At, B0); PG8_BAR; PG8_SCHED;
            PG8_STAGE(PG8_SB(1, 1), b3 + hstepB, voffB);
            PG8_WAIT_V(6); PG8_BAR; PG8_MMA(1, 1, At, B1); PG8_BAR;
            }
        }
        if constexpr (ALIGN_EPI) { if (wr == 0) PG8_BAR; }
        if constexpr (!Epi::AFTER_DRAIN) { E(acc, cur, wr, wc, fr, fq); S.done(cur); }
        if (!has_next) break;
#pragma unroll
        for (int a = 0; a < 2; ++a)
#pragma unroll
            for (int b = 0; b < 2; ++b)
#pragma unroll
                for (int m = 0; m < 4; ++m)
#pragma unroll
                    for (int n = 0; n < 2; ++n) acc[a][b][m][n] = (f32x4){0.f, 0.f, 0.f, 0.f};
        cur = nxt; cA = nA; cB = nB; ++ui;
        if constexpr (ALIGN_EPI) { if (wr == 1) PG8_BAR; }
    }
    PG8_WAIT_V(0);
    if constexpr (!ALIGN_EPI) { if (wr == 0) PG8_BAR; }
    PG8_BAR;
    if constexpr (Epi::AFTER_DRAIN) { E.fused(acc, cur, wr, wc, fr, fq, lds, wid, lane); S.done(cur); }
#undef PG8_SA
#undef PG8_SB
#undef PG8_STAGE
#undef PG8_LDA
#undef PG8_LDB
#undef PG8_MMA
#undef PG8_WAIT_V
#undef PG8_WAIT_L
#undef PG8_BAR
#undef PG8_SCHED
}
}

namespace att {
struct HalfUnit {
    const bf16* Q; long qs;
    const bf16* K; const bf16* V; long ks;
    int kc0, L, qc0, band;
    float c2;
    bf16* O; long os;
    float* lse; long ls;
    int mask;
};
#define KSWZ(row, colB) ((row) * 256 + ((colB) ^ (((row) & 7) << 4)))
__device__ __forceinline__ int crow(int r, int hi) { return (r & 3) + 8 * (r >> 2) + 4 * hi; }
__device__ __forceinline__ int v_st(int k, int c) { const int kk = (k & ~0xC) | ((k & 4) << 1) | ((k & 8) >> 1); return ((kk >> 3) * 4 + (c >> 5)) * 512 + ((kk & 7) * 32 + (c & 31)) * 2; }
__device__ __forceinline__ int v_rd_base(int lane) { return ((lane & 3) << 3) | (((lane >> 2) & 3) << 6) | (((lane >> 4) & 1) << 5) | (((lane >> 5) & 1) << 8); }
constexpr int v_rd_off(int d0, int ks, int half) { return d0 * 512 + ks * 4096 + half * 2048; }
template <int OFF> __device__ __forceinline__ s16x4 tr_read(int vb) {
    s16x4 r; asm volatile("ds_read_b64_tr_b16 %0, %1 offset:%2" : "=&v"(r) : "v"(vb), "i"(OFF) : "memory"); return r;
}
template <int D0> __device__ __forceinline__ void pv_one(f32x16& od, int vb, bf16x8 pa0, bf16x8 pa1, bf16x8 pa2, bf16x8 pa3) {
    const s16x4 l0 = tr_read<v_rd_off(D0, 0, 0)>(vb), h0 = tr_read<v_rd_off(D0, 0, 1)>(vb), l1 = tr_read<v_rd_off(D0, 1, 0)>(vb), h1 = tr_read<v_rd_off(D0, 1, 1)>(vb);
    const s16x4 l2 = tr_read<v_rd_off(D0, 2, 0)>(vb), h2 = tr_read<v_rd_off(D0, 2, 1)>(vb), l3 = tr_read<v_rd_off(D0, 3, 0)>(vb), h3 = tr_read<v_rd_off(D0, 3, 1)>(vb);
    asm volatile("s_waitcnt lgkmcnt(0)" ::: "memory"); __builtin_amdgcn_sched_barrier(0);
#define PK(L, H) (bf16x8){L[0], L[1], L[2], L[3], H[0], H[1], H[2], H[3]}
    od = __builtin_amdgcn_mfma_f32_32x32x16_bf16(pa0, PK(l0, h0), od, 0, 0, 0);
    od = __builtin_amdgcn_mfma_f32_32x32x16_bf16(pa1, PK(l1, h1), od, 0, 0, 0);
    od = __builtin_amdgcn_mfma_f32_32x32x16_bf16(pa2, PK(l2, h2), od, 0, 0, 0);
    od = __builtin_amdgcn_mfma_f32_32x32x16_bf16(pa3, PK(l3, h3), od, 0, 0, 0);
#undef PK
}
__device__ __forceinline__ void qkt(f32x16& p0, f32x16& p1, const LAS char* Ks, const bf16x8 (&qr)[8], int r32, int hi) {
    p0 = f32x16{}; p1 = f32x16{};
#pragma unroll
    for (int d0 = 0; d0 < 8; ++d0) { const int cb = (d0 * 16 + hi * 8) * 2;
        const bf16x8 b0 = *(const LAS bf16x8*)(Ks + KSWZ(r32, cb));
        const bf16x8 b1 = *(const LAS bf16x8*)(Ks + KSWZ(32 + r32, cb));
        p0 = __builtin_amdgcn_mfma_f32_32x32x16_bf16(b0, qr[d0], p0, 0, 0, 0);
        p1 = __builtin_amdgcn_mfma_f32_32x32x16_bf16(b1, qr[d0], p1, 0, 0, 0); }
}

__device__ __forceinline__ void attn_pair(LAS char* lds, const HalfUnit& u) {
    const int tid = threadIdx.x, wave = __builtin_amdgcn_readfirstlane(tid >> 6), lane = tid & 63, r32 = lane & 31, hi = lane >> 5;
    const int hw = wave >> 2, w4 = wave & 3;
    LAS char* Kb = lds + hw * 65536; LAS char* Vb = Kb + 32768;
    LAS float* al_l = (LAS float*)(lds + 131072 + wave * 256); LAS float* li_l = al_l + 32;
    bf16x8 qr[8];
    { const bf16* qp = u.Q + (long)(w4 * 32 + r32) * u.qs + hi * 8;
#pragma unroll
      for (int d0 = 0; d0 < 8; ++d0) qr[d0] = *(const bf16x8*)(qp + d0 * 16); }
    unsigned offK[4], offV[4];
#pragma unroll
    for (int j = 0; j < 4; ++j) { const int q = (4 * j + w4) * 64 + lane;
        { const int row = q >> 4, slot = q & 15, chunk = slot ^ (row & 7); offK[j] = (unsigned)(row * (int)u.ks + chunk * 8) * 2u; }
        { const int sub = q >> 5, kk = (sub >> 2) * 8 + ((q & 31) >> 2), c8 = (sub & 3) * 4 + (q & 3); const int k = (kk & ~0xC) | ((kk & 4) << 1) | ((kk & 8) >> 1);
          offV[j] = (unsigned)(k * (int)u.ks + c8 * 8) * 2u; } }
#define ALOAD(kc, b) do { const char* kg = (const char*)(u.K + (long)(kc) * u.ks); const char* vg = (const char*)(u.V + (long)(kc) * u.ks); \
    _Pragma("unroll") for (int j = 0; j < 4; ++j) { \
        __builtin_amdgcn_global_load_lds((const unsigned*)(kg + offK[j]), (LAS unsigned*)(Kb + (b) * 16384 + (4 * j + w4) * 1024), 16, 0, 0); \
        __builtin_amdgcn_global_load_lds((const unsigned*)(vg + offV[j]), (LAS unsigned*)(Vb + (b) * 16384 + (4 * j + w4) * 1024), 16, 0, 0); } } while (0)
    float m_reg = -1e30f, l_reg = 0.f; f32x16 o[4] = {};
    const int qa = u.qc0 + 32 * w4;
    const float bandf = (float)u.band, c2 = u.c2;
    const bool tv0 = (u.kc0 >= 0 && u.kc0 < u.L);
    if (tv0) ALOAD(u.kc0, 0);
    asm volatile("s_waitcnt vmcnt(0)" ::: "memory");
    __syncthreads();
#pragma unroll 1
    for (int t = 0; t < 4; ++t) {
        const int kc = u.kc0 + 64 * t, kcn = kc + 64;
        const bool tv = (kc >= 0 && kc < u.L), tvn = (t < 3) && (kcn >= 0 && kcn < u.L);
        if (tvn) ALOAD(kcn, (t + 1) & 1);
        const bool act = tv && (kc <= qa + 31 + u.band) && (kc + 63 >= qa - u.band);
        if (act) {
            const int b = t & 1;
            f32x16 p0, p1;
            qkt(p0, p1, Kb + b * 16384, qr, r32, hi);
            constexpr float C1 = SCALE * LOG2E;
            float tmax = -1e30f;
            if (u.mask) {
                const float dbf = (float)(kc - qa - r32 + 4 * hi);
#pragma unroll
                for (int r = 0; r < 16; ++r) { const float d0 = fabsf(dbf + (float)((r & 3) + 8 * (r >> 2))), d1 = fabsf(dbf + (float)(32 + (r & 3) + 8 * (r >> 2)));
                    const float t0 = d0 <= bandf ? fmaf(-c2, d0, p0[r] * C1) : -1e30f, t1 = d1 <= bandf ? fmaf(-c2, d1, p1[r] * C1) : -1e30f;
                    p0[r] = t0; p1[r] = t1; tmax = fmaxf(tmax, fmaxf(t0, t1)); }
            } else {
#pragma unroll
                for (int r = 0; r < 16; ++r) { p0[r] *= C1; p1[r] *= C1; tmax = fmaxf(tmax, fmaxf(p0[r], p1[r])); }
            }
            { auto rr = __builtin_amdgcn_permlane32_swap(__float_as_uint(tmax), __float_as_uint(tmax), false, false);
              tmax = fmaxf(__uint_as_float(rr[0]), __uint_as_float(rr[1])); }
            const float mn = fmaxf(m_reg, tmax), alpha = __builtin_amdgcn_exp2f(m_reg - mn); m_reg = mn;
            float ps = 0.f;
#pragma unroll
            for (int r = 0; r < 16; ++r) { float e0 = __builtin_amdgcn_exp2f(p0[r] - mn), e1 = __builtin_amdgcn_exp2f(p1[r] - mn);
                e0 = p0[r] > -1e29f ? e0 : 0.f; e1 = p1[r] > -1e29f ? e1 : 0.f; p0[r] = e0; p1[r] = e1; ps += e0 + e1; }
            { auto rr = __builtin_amdgcn_permlane32_swap(__float_as_uint(ps), __float_as_uint(ps), false, false);
              ps = __uint_as_float(rr[0]) + __uint_as_float(rr[1]); }
            l_reg = l_reg * alpha + ps;
            if (__any(alpha < 1.f)) { if (hi == 0) al_l[r32] = alpha; asm volatile("s_waitcnt lgkmcnt(0)" ::: "memory");
#pragma unroll
                for (int r = 0; r < 16; ++r) { const float a = al_l[crow(r, hi)];
#pragma unroll
                    for (int d = 0; d < 4; ++d) o[d][r] *= a; }
                asm volatile("s_waitcnt lgkmcnt(0)" ::: "memory"); }
            bf16x8 pa0, pa1, pa2, pa3;
#define PK4(P, BASE, OUT) do { unsigned a0 = cvt_pk_bf16(P[BASE + 0], P[BASE + 1]), a1 = cvt_pk_bf16(P[BASE + 2], P[BASE + 3]);   \
    unsigned b0 = cvt_pk_bf16(P[BASE + 4], P[BASE + 5]), b1 = cvt_pk_bf16(P[BASE + 6], P[BASE + 7]);                              \
    auto r0 = __builtin_amdgcn_permlane32_swap(a0, b0, false, false); auto r1 = __builtin_amdgcn_permlane32_swap(a1, b1, false, false); \
    v4u w = {r0[0], r1[0], r0[1], r1[1]}; OUT = *reinterpret_cast<bf16x8*>(&w); } while (0)
            PK4(p0, 0, pa0); PK4(p0, 8, pa1); PK4(p1, 0, pa2); PK4(p1, 8, pa3);
#undef PK4
            const int vb = (int)(unsigned)(uintptr_t)(Vb + b * 16384) + v_rd_base(lane);
            pv_one<0>(o[0], vb, pa0, pa1, pa2, pa3); pv_one<1>(o[1], vb, pa0, pa1, pa2, pa3); pv_one<2>(o[2], vb, pa0, pa1, pa2, pa3); pv_one<3>(o[3], vb, pa0, pa1, pa2, pa3);
        }
        asm volatile("s_waitcnt vmcnt(0)" ::: "memory");
        __syncthreads();
    }
    if (hi == 0) li_l[r32] = l_reg; asm volatile("s_waitcnt lgkmcnt(0)" ::: "memory");
    bf16* Ow = u.O + (long)(w4 * 32) * u.os + r32;
#pragma unroll
    for (int r = 0; r < 16; ++r) { const int orow = crow(r, hi); const float rl = __builtin_amdgcn_rcpf(li_l[orow]);
#pragma unroll
        for (int d0 = 0; d0 < 4; ++d0) { const float v = o[d0][r] * rl; Ow[(long)orow * u.os + d0 * 32] = (bf16)(cvt_pk_bf16(v, v) & 0xffffu); } }
    if (u.lse != nullptr && hi == 0) u.lse[(long)(w4 * 32 + r32) * u.ls] = (m_reg + __builtin_amdgcn_logf(l_reg)) * LN2;
    asm volatile("s_waitcnt lgkmcnt(0)" ::: "memory");
    __syncthreads();
#undef ALOAD
}
}

constexpr int NWAVES = 8;
constexpr size_t MiB = 1u << 20;
constexpr int LDS_BYTES = 147456;
constexpr int LDS_MISC = 131072 + 2048;
constexpr size_t WS_CTL = 0, CTL_ZERO_BYTES = 64 * 1024;
constexpr size_t WS_WIN_A = 2 * MiB, WS_WKV_A = 12 * MiB, WS_WOUT_A = 14 * MiB, WS_WGU_A = 16 * MiB, WS_WDN_A = 27 * MiB;
constexpr size_t WS_XB = 34 * MiB, WS_MEMB = 66 * MiB, WS_KV_A = 70 * MiB, WS_PROJ0 = 74 * MiB, WS_OG = 234 * MiB, WS_LSE = 282 * MiB, WS_MIX = 283 * MiB;
constexpr size_t WS_X1 = 74 * MiB, WS_X1B = 138 * MiB, WS_H = 170 * MiB;
constexpr size_t WS_X2 = 300 * MiB, WS_X2B = 364 * MiB, WS_PROJ1 = 170 * MiB, WS_U = 202 * MiB, WS_ACS = 218 * MiB, WS_MIX1 = 250 * MiB;
constexpr size_t WS_CS = 400 * MiB, WS_TME = 416 * MiB, WS_TMO = 416 * MiB + 512 * 1024, WS_WIN_B = 417 * MiB, WS_WOUT_B = 419 * MiB, WS_WKV_B = 421 * MiB, WS_KV_B = 423 * MiB;
constexpr size_t WS_TSLOT = 1 * MiB, WS_GATES = 1 * MiB + 256 * 1024, WS_WDN_M = 2 * MiB, WS_WGU_M = 58 * MiB, WS_XS = 170 * MiB, WS_HM = 238 * MiB, WS_Y = 58 * MiB;
constexpr int CW_CNT = 8192;
constexpr size_t WS_NEED = 476 * MiB;
constexpr int CW_BAR = 1024;

#define XB_TMO      128
#define XB_XCNT(j)  (256  + 64 * (j))
#define XB_XSUB(j)  (1280 + 64 * (j))
#define XB_XGEN(j)  (2304 + 64 * (j))
#define XB_TOP      3328
#define XB_TOPGEN   3392
#define XCD_BAR_WORDS 3456
#define XB_SPIN_CAP (1u << 18)
__device__ __forceinline__ unsigned xb_ld(unsigned* p)              { return __hip_atomic_load(p, __ATOMIC_RELAXED, __HIP_MEMORY_SCOPE_AGENT); }
__device__ __forceinline__ unsigned xb_add(unsigned* p, unsigned v) { return __hip_atomic_fetch_add(p, v, __ATOMIC_RELAXED, __HIP_MEMORY_SCOPE_AGENT); }
__device__ __forceinline__ unsigned xb_xcc_id() { return (unsigned)__builtin_amdgcn_s_getreg((3 << 11) | 20) & 0xFu; }
#define XB_SPIN(cond, bar) do { unsigned _sp = 0; while (cond) { __builtin_amdgcn_s_sleep(1); \
    if ((++_sp & 255u) == 0u) { if (xb_ld(&(bar)[XB_TMO])) break; if (_sp > XB_SPIN_CAP) { atomicAdd(&(bar)[XB_TMO], 1u); break; } } } } while (0)
struct XcdBarrier { unsigned* bar; unsigned x; volatile LAS unsigned* st; };
__device__ __forceinline__ XcdBarrier xcd_barrier_post(unsigned* bar, volatile LAS unsigned* st) {
    XcdBarrier b; b.bar = bar; b.x = xb_xcc_id(); b.st = st;
    if (threadIdx.x == 0) (void)xb_add(&bar[XB_XCNT(b.x)], 1u);
    return b;
}
__device__ __forceinline__ void xcd_barrier_complete(unsigned* bar, unsigned x, unsigned& nloc, unsigned& nx) {
    const unsigned G = gridDim.x * gridDim.y * gridDim.z;
    unsigned sum, cnt, mine, sp = 0u;
    for (;;) {
        sum = 0u; cnt = 0u; mine = 0u;
#pragma unroll
        for (unsigned j = 0; j < 16; ++j) { const unsigned c = xb_ld(&bar[XB_XCNT(j)]); sum += c; cnt += (c > 0u) ? 1u : 0u; mine = (j == x) ? c : mine; }
        if (sum == G) break;
        __builtin_amdgcn_s_sleep(1);
        if ((++sp & 255u) == 0u) { if (xb_ld(&bar[XB_TMO])) break; if (sp > XB_SPIN_CAP) { atomicAdd(&bar[XB_TMO], 1u); break; } }
    }
    nloc = mine > 0u ? mine : 1u; nx = cnt > 0u ? cnt : 1u;
}
__device__ __forceinline__ void xcd_barrier(const XcdBarrier& b) {
    asm volatile("s_waitcnt vmcnt(0)" ::: "memory");
    __syncthreads();
    if (threadIdx.x == 0) {
        unsigned* bar = b.bar;
        __builtin_amdgcn_s_waitcnt(0);
        unsigned nloc = b.st[0], nx = b.st[1];
        if (nloc == 0u) { xcd_barrier_complete(bar, b.x, nloc, nx); b.st[0] = nloc; b.st[1] = nx; }
        const unsigned old = xb_add(&bar[XB_XSUB(b.x)], 1u);
        const unsigned gen = old / nloc;
        if (old + 1u == (gen + 1u) * nloc) {
            __builtin_amdgcn_fence(__ATOMIC_RELEASE, "agent");
            asm volatile("s_waitcnt vmcnt(0)" ::: "memory");
            const unsigned og = xb_add(&bar[XB_TOP], 1u);
            const unsigned tg = og / nx;
            if (og + 1u == (tg + 1u) * nx) xb_add(&bar[XB_TOPGEN], 1u);
            else XB_SPIN(xb_ld(&bar[XB_TOPGEN]) == tg, bar);
            __builtin_amdgcn_fence(__ATOMIC_ACQUIRE, "agent");
            xb_add(&bar[XB_XGEN(b.x)], 1u);
            asm volatile("s_waitcnt vmcnt(0)" ::: "memory");
        } else {
            XB_SPIN(xb_ld(&bar[XB_XGEN(b.x)]) == gen, bar);
            __builtin_amdgcn_fence(__ATOMIC_ACQUIRE, "agent");
            asm volatile("s_waitcnt vmcnt(0)" ::: "memory");
        }
    }
    __syncthreads();
}

struct Args { const float* in[25]; float* out; unsigned char* ws; int ph_lo, ph_hi; };

__device__ __forceinline__ void transpose_item(const float* __restrict__ W, int K, int N, bf16* __restrict__ WT, int mode, int row_off, LAS float* scr, int item, int lane) {
    const int nblk = N / 64, kb = item / nblk, nb = item - kb * nblk, k0 = 64 * kb, n0 = 64 * nb;
    const float* src = W + (size_t)k0 * N + n0 + lane;
#pragma unroll 16
    for (int i = 0; i < 64; ++i) scr[i * 65 + lane] = src[(size_t)i * N];
    asm volatile("s_waitcnt lgkmcnt(0)" ::: "memory");
    const int c = lane & 7;
#pragma unroll
    for (int j = 0; j < 8; ++j) { const int n = (lane >> 3) + 8 * j; const LAS float* s = scr + (8 * c) * 65 + n;
        v4u o; o.x = cvt_pk_bf16(s[0 * 65], s[1 * 65]); o.y = cvt_pk_bf16(s[2 * 65], s[3 * 65]); o.z = cvt_pk_bf16(s[4 * 65], s[5 * 65]); o.w = cvt_pk_bf16(s[6 * 65], s[7 * 65]);
        const int ng = n0 + n; const int dr = mode == 0 ? row_off + ng : (ng >> 7) * 256 + (ng & 127) + row_off;
        *(v4u*)(WT + (size_t)dr * K + k0 + 8 * c) = o; }
    asm volatile("s_waitcnt lgkmcnt(0)" ::: "memory");
}
__device__ __forceinline__ void cvt_rows(const float* __restrict__ src, bf16* __restrict__ dst, size_t n8, size_t i0, size_t stride) {
    for (size_t i = i0; i < n8; i += stride) { const f32x4 a = *(const f32x4*)(src + i * 8), b = *(const f32x4*)(src + i * 8 + 4);
        v4u o; o.x = cvt_pk_bf16(a[0], a[1]); o.y = cvt_pk_bf16(a[2], a[3]); o.z = cvt_pk_bf16(b[0], b[1]); o.w = cvt_pk_bf16(b[2], b[3]); *(v4u*)(dst + i * 8) = o; }
}

struct P1Order {
    const char* xb; const char* win; char* proj; const char* memb; const char* wkv; char* kv; const char* wkv2; char* kv2; int G, c;
    __device__ __forceinline__ bool next(int i, pg8::Unit& u) const {
        const int L = i * G + c; int pm, pn;
        if (L < 1280) { pg8::tile_order(L, 64, 20, pm, pn); u.A = xb + (size_t)pm * 256 * D * 2; u.B = win + (size_t)pn * 256 * D * 2; u.C = proj + ((size_t)pm * 256 * PROJA + pn * 256) * 2; u.aux = 0; return true; }
        int l2 = L - 1280; if (l2 >= 64) return false;
        const bool second = l2 >= 32; l2 &= 31;
        pm = l2 >> 2; pn = l2 & 3; u.A = memb + (size_t)pm * 256 * D * 2; u.B = (second ? wkv2 : wkv) + (size_t)pn * 256 * D * 2; u.C = (second ? kv2 : kv) + ((size_t)pm * 256 * 1024 + pn * 256) * 2; u.aux = 1024; return true;
    }
    __device__ __forceinline__ void a_ready(const pg8::Unit&) const {}
    __device__ __forceinline__ void done(const pg8::Unit&) const {}
};
struct EpiBf16V {
    static constexpr bool PERM = true, AFTER_DRAIN = false;
    int ldc;
    __device__ __forceinline__ void operator()(const f32x4 (&acc)[2][2][4][2], const pg8::Unit& u, int wr, int wc, int fr, int fq) const {
        pg8::EpiBf16 e{u.aux ? u.aux : ldc, 128 * (u.aux ? u.aux : ldc), 1.f}; e(acc, u, wr, wc, fr, fq);
    }
};

struct ChanOrder {
    const char* tme; const char* tmo; const char* u; char* acs; int G, c;
    __device__ __forceinline__ bool next(int i, pg8::Unit& un) const {
        const int L = i * G + c; if (L >= 256) return false;
        const int g = L & 3, pn = L >> 2, b = pn >> 3, s0 = (pn & 7) * 256;
        un.A = tme + (size_t)(g & 1) * (WS_TMO - WS_TME); un.B = u + ((size_t)pn * 256 * 512 + (g & ~1) * 128) * 2; un.C = acs + (((size_t)b * 512 + g * 128) * 4096 + s0) * 2; un.aux = 0; return true;
    }
    __device__ __forceinline__ void a_ready(const pg8::Unit&) const {}
    __device__ __forceinline__ void done(const pg8::Unit&) const {}
};
struct SeqOrder {
    const char* cs; const char* acs; char* mix; int G, c;
    __device__ __forceinline__ bool next(int i, pg8::Unit& un) const {
        const int L = i * G + c; if (L >= 128) return false;
        const int b = L >> 4, pm = (L & 15) >> 1, pn = L & 1;
        un.A = cs + (size_t)pm * 256 * 4096 * 2; un.B = acs + ((size_t)b * 512 + pn * 256) * 4096 * 2; un.C = mix + (((size_t)b * SEQ + pm * 256) * D + pn * 256) * 2; un.aux = 0; return true;
    }
    __device__ __forceinline__ void a_ready(const pg8::Unit&) const {}
    __device__ __forceinline__ void done(const pg8::Unit&) const {}
};

struct MoeOrder {
    const char* A; const char* B; char* C; int G, c, nN, nRT; int t1, t2, t3, t4, t5, t6, t7; size_t aT, bE, bT, cTm, cTn;
    __device__ void init(const unsigned* cnt, const void* A_, int lda, const void* B_, int ldb, int nrows_e, void* C_, int ldc, int csz, int cw, int nN_, int G_, int c_) {
        int tp[9]; tp[0] = 0;
#pragma unroll
        for (int e = 0; e < 8; ++e) tp[e + 1] = tp[e] + (int)((__hip_atomic_load(cnt + e, __ATOMIC_RELAXED, __HIP_MEMORY_SCOPE_AGENT) + 255u) >> 8);
        t1 = tp[1]; t2 = tp[2]; t3 = tp[3]; t4 = tp[4]; t5 = tp[5]; t6 = tp[6]; t7 = tp[7]; nRT = tp[8];
        A = (const char*)A_; B = (const char*)B_; C = (char*)C_; G = G_; c = c_; nN = nN_;
        aT = (size_t)256 * lda * 2; bE = (size_t)nrows_e * ldb * 2; bT = (size_t)256 * ldb * 2; cTm = (size_t)256 * ldc * csz; cTn = (size_t)cw * csz; }
    __device__ __forceinline__ bool next(int i, pg8::Unit& u) const { int rt, pn; if (!pg8::tile_order(i * G + c, nRT, nN, rt, pn)) return false;
        const int e = (rt >= t1) + (rt >= t2) + (rt >= t3) + (rt >= t4) + (rt >= t5) + (rt >= t6) + (rt >= t7);
        u.A = A + rt * aT; u.B = B + e * bE + pn * bT; u.C = C + rt * cTm + pn * cTn; u.aux = 0; return true; }
    __device__ __forceinline__ void a_ready(const pg8::Unit&) const {}
    __device__ __forceinline__ void done(const pg8::Unit&) const {}
};

__device__ __forceinline__ att::HalfUnit make_half_unit(int hu, const bf16* proj, int ldp, int qmem_col, const bf16* kv, bf16* og, float* lse, bf16* mix, bool dilated_enabled) {
    att::HalfUnit u; const int kind = hu >> 9, idx = hu & 511;
    if (kind < 3) {
        const int g = kind, dil = g == 0 ? 1 : (g == 1 ? 4 : 16);
        int b, h, r, J;
        if (g == 0) { b = idx >> 6; h = (idx >> 4) & 3; r = 0; J = idx & 15; }
        else if (g == 1) { b = idx >> 6; h = (idx >> 4) & 3; r = (idx >> 2) & 3; J = idx & 3; }
        else { b = idx >> 6; h = (idx >> 4) & 3; r = idx & 15; J = 0; }
        const int hh = g * 4 + h; const long tok0 = (long)b * SEQ + r;
        const long tq = tok0 + (long)dil * 128 * J;
        u.Q = proj + tq * ldp + hh * HD; u.qs = (long)dil * ldp;
        u.K = proj + tok0 * ldp + 1536 + hh * HD; u.V = proj + tok0 * ldp + 3072 + hh * HD; u.ks = (long)dil * ldp;
        u.kc0 = 128 * J - 64; u.L = SEQ / dil; u.qc0 = 128 * J; u.band = 64;
        u.c2 = exp2f(-(float)(hh + 1) * (8.0f / 12.0f)) * (float)dil * LOG2E;
        u.O = og + (size_t)g * T * 512 + tq * 512 + h * HD; u.os = (long)dil * 512;
        u.lse = lse + (size_t)g * T * 4 + tq * 4 + h; u.ls = (long)dil * 4; u.mask = 1;
    } else {
        const int b = idx >> 6, h = (idx >> 4) & 3, J = idx & 15; const long tq = (long)b * SEQ + 128 * J;
        u.Q = proj + tq * ldp + qmem_col + h * HD; u.qs = ldp;
        u.K = kv + (long)b * NMEM * 1024 + h * HD; u.V = u.K + 512; u.ks = 1024;
        u.kc0 = 0; u.L = NMEM; u.qc0 = 0; u.band = 1 << 20; u.c2 = 0.f;
        u.O = mix + tq * D + 512 + h * HD; u.os = D; u.lse = nullptr; u.ls = 0; u.mask = 0;
    }
    (void)dilated_enabled;
    return u;
}

__device__ __forceinline__ void ln_rows(const float* in, const float* gam, const float* bet, float* of, bf16* ob, int gw, int NGW, int lane) {
    f32x4 gv[4], bv[4];
#pragma unroll
    for (int j = 0; j < 4; ++j) { gv[j] = *(const f32x4*)(gam + 4 * lane + 256 * j); bv[j] = *(const f32x4*)(bet + 4 * lane + 256 * j); }
    for (int m = gw; m < T; m += NGW) {
        const float* p = in + (size_t)m * D + 4 * lane;
        f32x4 v[4]; float s = 0.f;
#pragma unroll
        for (int j = 0; j < 4; ++j) { v[j] = *(const f32x4*)(p + 256 * j); s += (v[j][0] + v[j][1]) + (v[j][2] + v[j][3]); }
        const float mean = wave_sum(s) * (1.f / D); float q = 0.f;
#pragma unroll
        for (int j = 0; j < 4; ++j) { v[j] = v[j] - mean; q += (v[j][0] * v[j][0] + v[j][1] * v[j][1]) + (v[j][2] * v[j][2] + v[j][3] * v[j][3]); }
        const float rstd = rsqrtf(wave_sum(q) * (1.f / D) + LN_EPS);
#pragma unroll
        for (int j = 0; j < 4; ++j) { const f32x4 o = v[j] * rstd * gv[j] + bv[j];
            if (of) *(f32x4*)(of + (size_t)m * D + 4 * lane + 256 * j) = o;
            if (ob) { v2u w; w.x = cvt_pk_bf16(o[0], o[1]); w.y = cvt_pk_bf16(o[2], o[3]); *(v2u*)(ob + (size_t)m * D + 4 * lane + 256 * j) = w; } }
    }
}

__global__ void __launch_bounds__(NWAVES * 64, 2) mk_fwd(Args args) {
    extern __shared__ __attribute__((aligned(16))) unsigned char lds_raw[];
    LAS unsigned char* lds = (LAS unsigned char*)lds_raw;
    const int tid = threadIdx.x, lane = tid & 63, wave = __builtin_amdgcn_readfirstlane(tid >> 6);
    const int G = gridDim.x; const int bx = blockIdx.x; const int vcu = (G % 8 == 0) ? (bx % 8) * (G / 8) + bx / 8 : bx;
    unsigned char* ws = args.ws;
    unsigned* ctl = (unsigned*)(ws + WS_CTL);
    volatile LAS unsigned* MISC = (volatile LAS unsigned*)(lds + LDS_MISC);
    for (int u = tid; u < (LDS_BYTES - LDS_MISC) / 4; u += NWAVES * 64) ((LAS unsigned*)(lds + LDS_MISC))[u] = 0u;
    __syncthreads();
    const int lo = args.ph_lo, hi = args.ph_hi;
    XcdBarrier bar; bar.bar = ctl + CW_BAR; bar.x = 0; bar.st = nullptr;
    if (hi - lo > 1) bar = xcd_barrier_post(ctl + CW_BAR, MISC + 8);
#define IN(k) (lo <= (k) && (k) < hi)
#define SEAM(k) do { if (IN(k) && IN((k) + 1)) xcd_barrier(bar); } while (0)
    const float* x = args.in[0]; const float* mem = args.in[1];
    bf16* Win_a = (bf16*)(ws + WS_WIN_A); bf16* Wkv_a = (bf16*)(ws + WS_WKV_A); bf16* Wout_a = (bf16*)(ws + WS_WOUT_A);
    bf16* Wgu_a = (bf16*)(ws + WS_WGU_A); bf16* Wdn_a = (bf16*)(ws + WS_WDN_A); float* x1 = (float*)(ws + WS_X1); bf16* x1b = (bf16*)(ws + WS_X1B); bf16* hb = (bf16*)(ws + WS_H);
    float* x2 = (float*)(ws + WS_X2); bf16* x2b = (bf16*)(ws + WS_X2B); bf16* proj1 = (bf16*)(ws + WS_PROJ1); bf16* ub = (bf16*)(ws + WS_U); bf16* ACS = (bf16*)(ws + WS_ACS); bf16* mix1 = (bf16*)(ws + WS_MIX1);
    bf16* CSm = (bf16*)(ws + WS_CS); bf16* TmE = (bf16*)(ws + WS_TME); bf16* TmO = (bf16*)(ws + WS_TMO); bf16* Win_b = (bf16*)(ws + WS_WIN_B); bf16* Wout_b = (bf16*)(ws + WS_WOUT_B); bf16* Wkv_b = (bf16*)(ws + WS_WKV_B); bf16* kv_b = (bf16*)(ws + WS_KV_B);
    unsigned* tslot = (unsigned*)(ws + WS_TSLOT); float* gates = (float*)(ws + WS_GATES); bf16* Wdn_m = (bf16*)(ws + WS_WDN_M); bf16* Wgu_m = (bf16*)(ws + WS_WGU_M); bf16* xs = (bf16*)(ws + WS_XS); bf16* Hm = (bf16*)(ws + WS_HM); float* Ym = (float*)(ws + WS_Y);
    unsigned* cnt = ctl + CW_CNT;
    bf16* xb = (bf16*)(ws + WS_XB); bf16* memb = (bf16*)(ws + WS_MEMB); bf16* kv_a = (bf16*)(ws + WS_KV_A); bf16* proj0 = (bf16*)(ws + WS_PROJ0);
    bf16* og = (bf16*)(ws + WS_OG); float* lse = (float*)(ws + WS_LSE); bf16* mix = (bf16*)(ws + WS_MIX);
    const int gw = vcu * NWAVES + wave, NGW = G * NWAVES;

    if (IN(0)) {
        LAS float* scr = (LAS float*)(lds + wave * 16640);
        constexpr int I_IN = (D / 64) * (PROJA / 64), I_SQ = (D / 64) * (D / 64);
        constexpr int I_GU = (D / 64) * (DFF / 64), I_DN = (DFF / 64) * (D / 64);
        constexpr int NITEMS = I_IN + 5 * I_SQ + 2 * I_GU + I_DN;
        for (int it = gw; it < NITEMS; it += NGW) {
            int r = it;
            if (r < I_IN) { transpose_item(args.in[2], D, PROJA, Win_a, 0, 0, scr, r, lane); continue; } r -= I_IN;
            if (r < I_SQ) { transpose_item(args.in[3], D, 1024, Wkv_a, 0, 0, scr, r, lane); continue; } r -= I_SQ;
            if (r < I_SQ) { transpose_item(args.in[4], D, D, Wout_a, 0, 0, scr, r, lane); continue; } r -= I_SQ;
            if (r < I_GU) { transpose_item(args.in[7], D, DFF, Wgu_a, 1, 0, scr, r, lane); continue; } r -= I_GU;
            if (r < I_GU) { transpose_item(args.in[8], D, DFF, Wgu_a, 1, 128, scr, r, lane); continue; } r -= I_GU;
            if (r < I_DN) { transpose_item(args.in[9], DFF, D, Wdn_a, 0, 0, scr, r, lane); continue; } r -= I_DN;
            if (r < I_SQ) { transpose_item(args.in[12], D, D, Win_b, 0, 0, scr, r, lane); continue; } r -= I_SQ;
            if (r < I_SQ) { transpose_item(args.in[14], D, D, Wkv_b, 0, 0, scr, r, lane); continue; } r -= I_SQ;
            transpose_item(args.in[15], D, D, Wout_b, 0, 0, scr, r, lane);
        }
        cvt_rows(x, xb, (size_t)T * D / 8, (size_t)bx * 512 + tid, (size_t)G * 512);
        for (size_t i = (size_t)bx * 512 + tid; i < (size_t)SEQ * 4096 / 2; i += (size_t)G * 512) { const int k = (int)(i / 2048), j = (int)(i % 2048) * 2, tt = j >> 11, s = j & 2047;
            const int i0 = (k * s) & 2047, i1 = (k * (s + 1)) & 2047; float a, b; if (tt == 0) { a = cospif(i0 * (1.f / 1024.f)); b = cospif(i1 * (1.f / 1024.f)); } else { a = -sinpif(i0 * (1.f / 1024.f)); b = -sinpif(i1 * (1.f / 1024.f)); }
            ((unsigned*)CSm)[i] = cvt_pk_bf16(a, b); }
        for (int i = bx * 512 + tid; i < 256 * 256; i += G * 512) { const int r = i >> 8, c = i & 255, tt = r >> 7, l = r & 127, cc = c & 127; const int ix = (l * cc) & 127;
            const float v = tt == 0 ? cospif(ix * (1.f / 64.f)) : sinpif(ix * (1.f / 64.f)); const bf16 vb = (bf16)(cvt_pk_bf16(v, v) & 0xffffu);
            TmE[i] = c < 128 ? vb : (bf16)0; TmO[i] = c < 128 ? (bf16)0 : vb; }
        cvt_rows(mem, memb, (size_t)BATCH * NMEM * D / 8, (size_t)bx * 512 + tid, (size_t)G * 512);
        __syncthreads();
    }
    SEAM(0);
    if (IN(1)) {
        P1Order S{(const char*)xb, (const char*)Win_a, (char*)proj0, (const char*)memb, (const char*)Wkv_a, (char*)kv_a, (const char*)Wkv_b, (char*)kv_b, G, bx};
        EpiBf16V E{PROJA};
        pg8::gemm_phase<EpiBf16V, P1Order, true, true>(lds, D, D, D, S, E);
    }
    SEAM(1);
    if (IN(2)) {
        for (int p = bx; p < 1024; p += G) {
            const int hu = 2 * p + (wave >> 2);
            const att::HalfUnit u = make_half_unit(hu, proj0, PROJA, QKVW, kv_a, og, lse, mix, true);
            att::attn_pair((LAS char*)lds, u);
        }
    }
    SEAM(2);
    if (IN(3)) {
        for (int tok = gw; tok < T; tok += NGW) {
            const int h = lane >> 4;
            const float l0 = lse[(size_t)tok * 4 + h], l1 = lse[(size_t)T * 4 + (size_t)tok * 4 + h], l2 = lse[(size_t)2 * T * 4 + (size_t)tok * 4 + h];
            const float M = fmaxf(fmaxf(l0, l1), l2);
            float w0 = __expf(l0 - M), w1 = __expf(l1 - M), w2 = __expf(l2 - M); const float wsum = 1.f / (w0 + w1 + w2); w0 *= wsum; w1 *= wsum; w2 *= wsum;
            const v4u a = *(const v4u*)(og + (size_t)tok * 512 + lane * 8), b = *(const v4u*)(og + (size_t)T * 512 + (size_t)tok * 512 + lane * 8), c = *(const v4u*)(og + (size_t)2 * T * 512 + (size_t)tok * 512 + lane * 8);
            v4u o;
#pragma unroll
            for (int j = 0; j < 4; ++j) { const float lo_ = w0 * __uint_as_float(a[j] << 16) + w1 * __uint_as_float(b[j] << 16) + w2 * __uint_as_float(c[j] << 16);
                const float hi_ = w0 * __uint_as_float(a[j] & 0xffff0000u) + w1 * __uint_as_float(b[j] & 0xffff0000u) + w2 * __uint_as_float(c[j] & 0xffff0000u);
                o[j] = cvt_pk_bf16(lo_, hi_); }
            *(v4u*)(mix + (size_t)tok * D + lane * 8) = o;
        }
    }
    SEAM(3);
    if (IN(4)) {
        pg8::PlainOrder S; S.init(mix, D, Wout_a, D, args.out, D, 4, 256, T, D, G, bx);
        pg8::EpiF32Res E{D, (long)((const char*)x - (const char*)args.out), ALPHA};
        pg8::gemm_phase<pg8::EpiF32Res, pg8::PlainOrder, true, true>(lds, D, D, D, S, E);
    }
    SEAM(4);
    if (IN(5)) ln_rows(args.out, args.in[5], args.in[6], x1, x1b, gw, NGW, lane);
    SEAM(5);
    if (IN(6)) {
        pg8::PlainOrder S; S.init(x1b, D, Wgu_a, D, hb, DFF, 2, 128, T, 2 * DFF, G, bx);
        pg8::EpiSwiGLU E{DFF};
        pg8::gemm_phase<pg8::EpiSwiGLU, pg8::PlainOrder, true, true>(lds, D, D, D, S, E);
    }
    SEAM(6);
    if (IN(7)) {
        pg8::PlainOrder S; S.init(hb, DFF, Wdn_a, DFF, args.out, D, 4, 256, T, D, G, bx);
        pg8::EpiF32Res E{D, (long)((const char*)x1 - (const char*)args.out), ALPHA};
        pg8::gemm_phase<pg8::EpiF32Res, pg8::PlainOrder, true, true>(lds, DFF, DFF, DFF, S, E);
    }
    SEAM(7);
    if (IN(8)) ln_rows(args.out, args.in[10], args.in[11], x2, x2b, gw, NGW, lane);
    SEAM(8);
    if (IN(9)) {
        pg8::PlainOrder S; S.init(x2b, D, Win_b, D, proj1, D, 2, 256, T, D, G, bx);
        pg8::EpiBf16 E{D, 128 * D, 1.f};
        pg8::gemm_phase<pg8::EpiBf16, pg8::PlainOrder, true, true>(lds, D, D, D, S, E);
    }
    SEAM(9);
    if (IN(10)) {
        const float* fg = args.in[13]; f32x4 g0 = *(const f32x4*)(fg + lane * 8), g1 = *(const f32x4*)(fg + lane * 8 + 4);
        for (int tok = gw; tok < T; tok += NGW) {
            const v4u raw = *(const v4u*)(proj1 + (size_t)tok * D + lane * 8); float v[8]; float s = 0.f;
#pragma unroll
            for (int j = 0; j < 4; ++j) { v[2 * j] = __uint_as_float(raw[j] << 16); v[2 * j + 1] = __uint_as_float(raw[j] & 0xffff0000u); s += v[2 * j] + v[2 * j + 1]; }
#pragma unroll
            for (int o = 1; o < 16; o <<= 1) s += __shfl_xor(s, o);
            const float mean = s * (1.f / 128.f); float q = 0.f;
#pragma unroll
            for (int j = 0; j < 8; ++j) { v[j] -= mean; q += v[j] * v[j]; }
#pragma unroll
            for (int o = 1; o < 16; o <<= 1) q += __shfl_xor(q, o);
            const float rstd = rsqrtf(q * (1.f / 128.f) + LN_EPS);
            v4u w; w.x = cvt_pk_bf16(v[0] * rstd * g0[0], v[1] * rstd * g0[1]); w.y = cvt_pk_bf16(v[2] * rstd * g0[2], v[3] * rstd * g0[3]);
            w.z = cvt_pk_bf16(v[4] * rstd * g1[0], v[5] * rstd * g1[1]); w.w = cvt_pk_bf16(v[6] * rstd * g1[2], v[7] * rstd * g1[3]);
            *(v4u*)(ub + (size_t)tok * 512 + lane * 8) = w;
        }
        __syncthreads();
        for (int p = 768 + bx; p < 1024; p += G) {
            const int hu = 2 * p + (wave >> 2);
            const att::HalfUnit u = make_half_unit(hu, proj1, D, 512, kv_b, og, lse, mix1, false);
            att::attn_pair((LAS char*)lds, u);
        }
    }
    SEAM(10);
    if (IN(11)) {
        ChanOrder S{(const char*)TmE, (const char*)TmO, (const char*)ub, (char*)ACS, G, bx};
        pg8::EpiBf16 E{4096, 2048, 1.f};
        pg8::gemm_phase<pg8::EpiBf16, ChanOrder, true, true>(lds, 256, 256, 512, S, E);
    }
    SEAM(11);
    if (IN(12)) {
        SeqOrder S{(const char*)CSm, (const char*)ACS, (char*)mix1, G, bx};
        pg8::EpiBf16 E{D, 128 * D, 1.f / 512.f};
        pg8::gemm_phase<pg8::EpiBf16, SeqOrder, true, true>(lds, 4096, 4096, 4096, S, E);
        if (bx >= 128 || G < 256) {
            LAS float* scr = (LAS float*)(lds + wave * 16640);
            constexpr int I_G = (D / 64) * (DFE / 64);
            const int nw = (G < 256) ? NGW : (G - 128) * NWAVES, w0 = (G < 256) ? gw : (bx - 128) * NWAVES + wave;
            for (int it = w0; it < 24 * I_G; it += nw) { const int mtx = it / I_G, r = it - mtx * I_G, e = mtx % 8, kind = mtx / 8;
                if (kind == 0) transpose_item(args.in[20] + (size_t)e * D * DFE, D, DFE, Wgu_m + (size_t)e * 2 * DFE * D, 1, 0, scr, r, lane);
                else if (kind == 1) transpose_item(args.in[21] + (size_t)e * D * DFE, D, DFE, Wgu_m + (size_t)e * 2 * DFE * D, 1, 128, scr, r, lane);
                else transpose_item(args.in[22] + (size_t)e * DFE * D, DFE, D, Wdn_m + (size_t)e * D * DFE, 0, 0, scr, r, lane); }
        }
    }
    SEAM(12);
    if (IN(13)) {
        pg8::PlainOrder S; S.init(mix1, D, Wout_b, D, args.out, D, 4, 256, T, D, G, bx);
        pg8::EpiF32Res E{D, (long)((const char*)x2 - (const char*)args.out), ALPHA};
        pg8::gemm_phase<pg8::EpiF32Res, pg8::PlainOrder, true, true>(lds, D, D, D, S, E);
    }
    SEAM(13);
    if (IN(14)) {
        LAS float* rwl = (LAS float*)lds;
        LAS int* s_e = (LAS int*)(lds + 32768);
        LAS float* s_g = (LAS float*)(lds + 32768 + 512);
        { const float* rw = args.in[18];
#pragma unroll
          for (int j = 0; j < 4; ++j) *(LAS f32x4*)(rwl + (tid + 512 * j) * 4) = *(const f32x4*)(rw + (tid + 512 * j) * 4); }
        float rb[8];
#pragma unroll
        for (int e = 0; e < 8; ++e) rb[e] = args.in[19][e];
        f32x4 gv[4], bv[4];
#pragma unroll
        for (int j = 0; j < 4; ++j) { gv[j] = *(const f32x4*)(args.in[16] + 4 * lane + 256 * j); bv[j] = *(const f32x4*)(args.in[17] + 4 * lane + 256 * j); }
        __syncthreads();
        for (int chunk = bx; chunk < T / 64; chunk += G) {
#pragma unroll 1
            for (int i = 0; i < 8; ++i) {
                const int tok = chunk * 64 + wave * 8 + i;
                float* p = args.out + (size_t)tok * D + 4 * lane;
                f32x4 v[4]; float s = 0.f;
#pragma unroll
                for (int j = 0; j < 4; ++j) { v[j] = *(const f32x4*)(p + 256 * j); s += (v[j][0] + v[j][1]) + (v[j][2] + v[j][3]); }
                const float mean = wave_sum(s) * (1.f / D); float q = 0.f;
#pragma unroll
                for (int j = 0; j < 4; ++j) { v[j] = v[j] - mean; q += (v[j][0] * v[j][0] + v[j][1] * v[j][1]) + (v[j][2] * v[j][2] + v[j][3] * v[j][3]); }
                const float rstd = rsqrtf(wave_sum(q) * (1.f / D) + LN_EPS);
                float lg[8];
#pragma unroll
                for (int e = 0; e < 8; ++e) lg[e] = 0.f;
#pragma unroll
                for (int j = 0; j < 4; ++j) { const f32x4 o = v[j] * rstd * gv[j] + bv[j]; *(f32x4*)(p + 256 * j) = o;
#pragma unroll
                    for (int qd = 0; qd < 4; ++qd) { const LAS float* wr_ = rwl + (4 * lane + 256 * j + qd) * 8; const f32x4 wa = *(const LAS f32x4*)wr_, wb = *(const LAS f32x4*)(wr_ + 4);
                        lg[0] += o[qd] * wa[0]; lg[1] += o[qd] * wa[1]; lg[2] += o[qd] * wa[2]; lg[3] += o[qd] * wa[3]; lg[4] += o[qd] * wb[0]; lg[5] += o[qd] * wb[1]; lg[6] += o[qd] * wb[2]; lg[7] += o[qd] * wb[3]; } }
#pragma unroll
                for (int e = 0; e < 8; ++e) lg[e] = wave_sum(lg[e]) + rb[e];
                int e1 = 0; float v1 = lg[0];
#pragma unroll
                for (int e = 1; e < 8; ++e) if (lg[e] > v1) { v1 = lg[e]; e1 = e; }
                int e2 = 0; float v2 = -3.4e38f;
#pragma unroll
                for (int e = 0; e < 8; ++e) if (e != e1 && lg[e] > v2) { v2 = lg[e]; e2 = e; }
                const float p2 = __expf(v2 - v1), g1 = 1.f / (1.f + p2), g2 = p2 / (1.f + p2);
                if (lane == 0) { s_e[(wave * 8 + i) * 2] = e1; s_e[(wave * 8 + i) * 2 + 1] = e2; s_g[(wave * 8 + i) * 2] = g1; s_g[(wave * 8 + i) * 2 + 1] = g2; }
            }
            __syncthreads();
            if (wave == 0) {
                const int tok = chunk * 64 + lane; const int e1 = s_e[lane * 2], e2 = s_e[lane * 2 + 1];
                const unsigned long long ltm = (1ull << lane) - 1ull; unsigned pos1 = 0, pos2 = 0;
#pragma unroll
                for (int e = 0; e < 8; ++e) { const unsigned long long m1 = __ballot(e1 == e), m2 = __ballot(e2 == e); const unsigned c1 = __popcll(m1), c2 = __popcll(m2);
                    unsigned base = 0; if (lane == 0 && c1 + c2 > 0) base = __hip_atomic_fetch_add(cnt + e, c1 + c2, __ATOMIC_RELAXED, __HIP_MEMORY_SCOPE_AGENT);
                    base = __builtin_amdgcn_readfirstlane(base);
                    if (e1 == e) pos1 = base + __popcll(m1 & ltm);
                    if (e2 == e) pos2 = base + c1 + __popcll(m2 & ltm); }
                tslot[tok * 2] = ((unsigned)e1 << 20) | pos1; tslot[tok * 2 + 1] = ((unsigned)e2 << 20) | pos2;
                gates[tok * 2] = s_g[lane * 2]; gates[tok * 2 + 1] = s_g[lane * 2 + 1];
            }
            __syncthreads();
        }
    }
    SEAM(14);
    if (IN(15)) {
        unsigned pr[8]; { unsigned acc_ = 0;
#pragma unroll
            for (int e = 0; e < 8; ++e) { pr[e] = acc_; acc_ += ((__hip_atomic_load(cnt + e, __ATOMIC_RELAXED, __HIP_MEMORY_SCOPE_AGENT) + 255u) >> 8) << 8; } }
        for (int tok = gw; tok < T; tok += NGW) {
            const float* p = args.out + (size_t)tok * D + 4 * lane;
            v2u w[4];
#pragma unroll
            for (int j = 0; j < 4; ++j) { const f32x4 v = *(const f32x4*)(p + 256 * j); w[j].x = cvt_pk_bf16(v[0], v[1]); w[j].y = cvt_pk_bf16(v[2], v[3]); }
#pragma unroll
            for (int k = 0; k < 2; ++k) { const unsigned ts = tslot[tok * 2 + k]; const unsigned e = ts >> 20, pos = ts & 0xfffffu; unsigned base = 0;
#pragma unroll
                for (int j = 0; j < 8; ++j) base = (e == (unsigned)j) ? pr[j] : base;
                const unsigned gs = base + pos; bf16* d = xs + (size_t)gs * D + 4 * lane;
#pragma unroll
                for (int j = 0; j < 4; ++j) *(v2u*)(d + 256 * j) = w[j];
                if (lane == 0) tslot[tok * 2 + k] = gs; }
        }
    }
    SEAM(15);
    if (IN(16)) {
        MoeOrder S; S.init(cnt, xs, D, Wgu_m, D, 2 * DFE, Hm, DFE, 2, 128, 28, G, bx);
        pg8::EpiSwiGLU E{DFE};
        pg8::gemm_phase<pg8::EpiSwiGLU, MoeOrder, true, true>(lds, D, D, D, S, E);
    }
    SEAM(16);
    if (IN(17)) {
        MoeOrder S; S.init(cnt, Hm, DFE, Wdn_m, DFE, D, Ym, D, 4, 256, 4, G, bx);
        pg8::EpiF32Res E{D, 0, 0.f};
        pg8::gemm_phase<pg8::EpiF32Res, MoeOrder, true, true>(lds, DFE, DFE, DFE, S, E);
    }
    SEAM(17);
    if (IN(18)) {
        f32x4 gv[4], bv[4];
#pragma unroll
        for (int j = 0; j < 4; ++j) { gv[j] = *(const f32x4*)(args.in[23] + 4 * lane + 256 * j); bv[j] = *(const f32x4*)(args.in[24] + 4 * lane + 256 * j); }
        for (int tok = gw; tok < T; tok += NGW) {
            float* p = args.out + (size_t)tok * D + 4 * lane;
            const unsigned s1 = tslot[tok * 2], s2 = tslot[tok * 2 + 1]; const float g1 = gates[tok * 2], g2 = gates[tok * 2 + 1];
            const float* y1 = Ym + (size_t)s1 * D + 4 * lane; const float* y2 = Ym + (size_t)s2 * D + 4 * lane;
            f32x4 v[4]; float s = 0.f;
#pragma unroll
            for (int j = 0; j < 4; ++j) { v[j] = *(const f32x4*)(p + 256 * j) * ALPHA + *(const f32x4*)(y1 + 256 * j) * g1 + *(const f32x4*)(y2 + 256 * j) * g2; s += (v[j][0] + v[j][1]) + (v[j][2] + v[j][3]); }
            const float mean = wave_sum(s) * (1.f / D); float q = 0.f;
#pragma unroll
            for (int j = 0; j < 4; ++j) { v[j] = v[j] - mean; q += (v[j][0] * v[j][0] + v[j][1] * v[j][1]) + (v[j][2] * v[j][2] + v[j][3] * v[j][3]); }
            const float rstd = rsqrtf(wave_sum(q) * (1.f / D) + LN_EPS);
#pragma unroll
            for (int j = 0; j < 4; ++j) *(f32x4*)(p + 256 * j) = v[j] * rstd * gv[j] + bv[j];
        }
    }
#undef IN
#undef SEAM
}
constexpr int N_PHASES = 19;

#ifndef MK_SINGLE
#define MK_SINGLE 1
#endif
extern "C" void kernel_launch(void* const* d_in, const int* in_sizes, int n_in, void* d_out, int out_size, void* d_ws, size_t ws_size, hipStream_t stream) {
    static int grid = 0;
    if (grid == 0) {
        if (n_in != 25 || out_size != T * D || ws_size < WS_NEED) { fprintf(stderr, "kernel_launch: unexpected shapes (n_in %d out %d ws %zu)\n", n_in, out_size, ws_size); grid = -1; return; }
        int dev = 0, cus = 0;
        if (hipGetDevice(&dev) != hipSuccess || hipDeviceGetAttribute(&cus, hipDeviceAttributeMultiprocessorCount, dev) != hipSuccess) { grid = -1; return; }
        if (hipFuncSetAttribute((const void*)mk_fwd, hipFuncAttributeMaxDynamicSharedMemorySize, LDS_BYTES) != hipSuccess) { fprintf(stderr, "kernel_launch: hipFuncSetAttribute failed\n"); grid = -1; return; }
        int per_cu = 0;
        if (hipOccupancyMaxActiveBlocksPerMultiprocessor(&per_cu, (const void*)mk_fwd, NWAVES * 64, LDS_BYTES) != hipSuccess || per_cu < 1) { fprintf(stderr, "kernel_launch: occupancy query says %d\n", per_cu); }
        (void)hipGetLastError();
        grid = cus;
    }
    if (grid < 0) return;
    float* out = (float*)d_out;
    char* ws = (char*)d_ws;
    (void)hipMemsetAsync(ws + WS_CTL, 0, CTL_ZERO_BYTES, stream);
    Args a{};
    for (int i = 0; i < 25; ++i) a.in[i] = (const float*)d_in[i];
    a.out = out; a.ws = (unsigned char*)d_ws;
    if (MK_SINGLE) { a.ph_lo = 0; a.ph_hi = N_PHASES; hipLaunchKernelGGL(mk_fwd, dim3(grid), dim3(NWAVES * 64), LDS_BYTES, stream, a); }
    else for (int ph = 0; ph < N_PHASES; ++ph) { a.ph_lo = ph; a.ph_hi = ph + 1; hipLaunchKernelGGL(mk_fwd, dim3(grid), dim3(NWAVES * 64), LDS_BYTES, stream, a); }
}
```

```cpp
#include <hip/hip_runtime.h>
#include <cstdio>
#include <cstdint>

constexpr int D = 1024, BATCH = 8, SEQ = 2048, T = BATCH * SEQ;
constexpr int HD = 128, QKVW = 4608, PROJA = 5120, NMEM = 256;
constexpr int DFF = 2816, NE = 8, DFE = 3584;
constexpr float ALPHA = 1.4142135623730951f;
constexpr float LN_EPS = 1e-5f;
constexpr float SCALE = 0.08838834764831845f;
constexpr float LOG2E = 1.4426950408889634f, LN2 = 0.6931471805599453f;

#define GAS __attribute__((address_space(1)))
#define LAS __attribute__((address_space(3)))
typedef unsigned short bf16;
typedef unsigned v4u __attribute__((ext_vector_type(4)));
typedef unsigned v2u __attribute__((ext_vector_type(2)));
typedef float f32x4 __attribute__((ext_vector_type(4)));
typedef float f32x2 __attribute__((ext_vector_type(2)));
typedef float f32x16 __attribute__((ext_vector_type(16)));
typedef short bf16x8 __attribute__((ext_vector_type(8)));
typedef short s16x4 __attribute__((ext_vector_type(4)));

__device__ __forceinline__ int lane_id() { return (int)__builtin_amdgcn_mbcnt_hi(~0u, __builtin_amdgcn_mbcnt_lo(~0u, 0u)); }
__device__ __forceinline__ float wave_sum(float v) {
#pragma unroll
    for (int o = 1; o < 64; o <<= 1) v += __shfl_xor(v, o);
    return v;
}
__device__ __forceinline__ float wave_max(float v) {
#pragma unroll
    for (int o = 1; o < 64; o <<= 1) v = fmaxf(v, __shfl_xor(v, o));
    return v;
}
__device__ __forceinline__ unsigned cvt_pk_bf16(float lo, float hi) { unsigned r; asm volatile("v_cvt_pk_bf16_f32 %0, %1, %2" : "=v"(r) : "v"(lo), "v"(hi)); return r; }
__device__ __forceinline__ float bf2f(unsigned short b) { return __uint_as_float(((unsigned)b) << 16); }

namespace pg8 {
#define PG8_LAS __attribute__((address_space(3)))
typedef int v4i_t __attribute__((ext_vector_type(4)));
typedef int v8i_t __attribute__((ext_vector_type(8)));
constexpr int BM = 256, BK = 64, HALF = 128, HTB = HALF * BK * 2  , STAGE_BYTES = 8 * HTB, NXCD = 8, WGM = 8;
__host__ __device__ __forceinline__ int lds_byte(int r, int c) { const int st = (r >> 4) * 2 + (c >> 5), rr = r & 15, cc = c & 31, ob = rr * 64 + cc * 2; return st * 1024 + (ob ^ (((ob >> 9) & 1) << 5)); }
__host__ __device__ __forceinline__ void stage_rc(int b, int& R, int& C) { const int st = b / 1024, sb = b % 1024, swz = sb ^ (((sb >> 9) & 1) << 5); R = (st >> 1) * 16 + swz / 64; C = (st & 1) * 32 + (swz % 64) / 2; }
__host__ __device__ __forceinline__ int perm32(int rho) { const int n = rho >> 4, i = rho & 15; return 8 * (i >> 2) + 4 * n + (i & 3); }

struct Unit { const char* A; const char* B; char* C; int aux; };

__device__ __forceinline__ bool tile_order(int L, int nM, int nN, int& pm, int& pn) {
    const int nwg = nM * nN; if (L >= nwg) return false;
    int wgid = L; { const int q = nwg / NXCD, r = nwg % NXCD, xcd = wgid % NXCD, off = wgid / NXCD; wgid = (xcd < r ? xcd * (q + 1) : r * (q + 1) + (xcd - r) * q) + off; }
    const int nig = WGM * nN, gid = wgid / nig, fm = gid * WGM, gsz = (nM - fm) < WGM ? (nM - fm) : WGM;
    pm = fm + ((wgid % nig) % gsz); pn = (wgid % nig) / gsz; return true;
}
struct PlainOrder {
    const char* A; const char* B; char* C; int nM, nN, G, c; size_t aT, bT, cTm, cTn;
    __device__ void init(const void* A_, int lda, const void* B_, int ldb, void* C_, int ldc, int csz, int cw, int M, int N, int G_, int c_) {
        A = (const char*)A_; B = (const char*)B_; C = (char*)C_; nM = M / BM; nN = N / BM; G = G_; c = c_;
        aT = (size_t)BM * lda * 2; bT = (size_t)BM * ldb * 2; cTm = (size_t)BM * ldc * csz; cTn = (size_t)cw * csz; }
    __device__ __forceinline__ bool next(int i, Unit& u) const { int pm, pn; if (!tile_order(i * G + c, nM, nN, pm, pn)) return false;
        u.A = A + pm * aT; u.B = B + pn * bT; u.C = C + pm * cTm + pn * cTn; u.aux = 0; return true; }
    __device__ __forceinline__ void a_ready(const Unit&) const {}
    __device__ __forceinline__ void done(const Unit&) const {}
};

struct EpiBf16 {
    static constexpr bool PERM = true, AFTER_DRAIN = false;
    int ldc; int hs; float s;
    __device__ __forceinline__ void operator()(const f32x4 (&acc)[2][2][4][2], const Unit& u, int wr, int wc, int fr, int fq) const {
        bf16* base = (bf16*)u.C + (wr * 64 + fr) * (size_t)ldc + wc * 32 + 8 * fq;
#pragma unroll
        for (int ai = 0; ai < 2; ++ai)
#pragma unroll
            for (int m = 0; m < 4; ++m) { bf16* rowp = base + (size_t)ai * hs + (size_t)(m * 16) * ldc;
#pragma unroll
                for (int bj = 0; bj < 2; ++bj) { const f32x4 v0 = acc[ai][bj][m][0] * s, v1 = acc[ai][bj][m][1] * s;
                    v4u w; w.x = cvt_pk_bf16(v0[0], v0[1]); w.y = cvt_pk_bf16(v0[2], v0[3]); w.z = cvt_pk_bf16(v1[0], v1[1]); w.w = cvt_pk_bf16(v1[2], v1[3]);
                    *(v4u*)(rowp + bj * HALF) = w; } }
    }
};
struct EpiSwiGLU {
    static constexpr bool PERM = true, AFTER_DRAIN = false;
    int ldc;
    __device__ __forceinline__ void operator()(const f32x4 (&acc)[2][2][4][2], const Unit& u, int wr, int wc, int fr, int fq) const {
        bf16* base = (bf16*)u.C + (wr * 64 + fr) * (size_t)ldc + wc * 32 + 8 * fq;
#pragma unroll
        for (int ai = 0; ai < 2; ++ai)
#pragma unroll
            for (int m = 0; m < 4; ++m) { bf16* rowp = base + (size_t)(ai * HALF + m * 16) * ldc; float h[8];
#pragma unroll
                for (int n = 0; n < 2; ++n)
#pragma unroll
                    for (int j = 0; j < 4; ++j) { const float g = acc[ai][0][m][n][j], up = acc[ai][1][m][n][j];
                        h[n * 4 + j] = g * __builtin_amdgcn_rcpf(1.f + __builtin_amdgcn_exp2f(-g * LOG2E)) * up; }
                v4u w; w.x = cvt_pk_bf16(h[0], h[1]); w.y = cvt_pk_bf16(h[2], h[3]); w.z = cvt_pk_bf16(h[4], h[5]); w.w = cvt_pk_bf16(h[6], h[7]);
                *(v4u*)rowp = w; }
    }
};
struct EpiSwiGLU8 {
    static constexpr bool PERM = true, AFTER_DRAIN = false;
    int ldc; float s;
    __device__ __forceinline__ void operator()(const f32x4 (&acc)[2][2][4][2], const Unit& u, int wr, int wc, int fr, int fq) const {
        unsigned char* const C0 = (unsigned char*)u.C; unsigned base = (unsigned)((wr * 64 + fr) * ldc + wc * 32 + 8 * fq); asm volatile("" : "+v"(base));
#pragma unroll
        for (int ai = 0; ai < 2; ++ai)
#pragma unroll
            for (int m = 0; m < 4; ++m) { unsigned char* rowp = C0 + (base + (unsigned)((ai * HALF + m * 16) * ldc)); float h[8];
#pragma unroll
                for (int n = 0; n < 2; ++n)
#pragma unroll
                    for (int j = 0; j < 4; ++j) { const float g = acc[ai][0][m][n][j] * s, up = acc[ai][1][m][n][j] * s;
                        h[n * 4 + j] = g * __builtin_amdgcn_rcpf(1.f + __builtin_amdgcn_exp2f(-g * LOG2E)) * up; }
                int w0 = 0, w1 = 0;
                w0 = __builtin_amdgcn_cvt_pk_fp8_f32(h[0], h[1], w0, false); w0 = __builtin_amdgcn_cvt_pk_fp8_f32(h[2], h[3], w0, true);
                w1 = __builtin_amdgcn_cvt_pk_fp8_f32(h[4], h[5], w1, false); w1 = __builtin_amdgcn_cvt_pk_fp8_f32(h[6], h[7], w1, true);
                v2u w; w.x = (unsigned)w0; w.y = (unsigned)w1; *(v2u*)rowp = w; }
    }
};
struct EpiF32Scale {
    static constexpr bool PERM = false, AFTER_DRAIN = false;
    int ldc; float s;
    __device__ __forceinline__ void operator()(const f32x4 (&acc)[2][2][4][2], const Unit& u, int wr, int wc, int fr, int fq) const {
        float* const C0 = (float*)u.C; unsigned base = (unsigned)((wr * 64 + fr) * ldc + wc * 32 + 4 * fq); asm volatile("" : "+v"(base));
#pragma unroll
        for (int ai = 0; ai < 2; ++ai)
#pragma unroll
            for (int m = 0; m < 4; ++m) { float* rowp = C0 + (base + (unsigned)((ai * HALF + m * 16) * ldc));
#pragma unroll
                for (int bj = 0; bj < 2; ++bj)
#pragma unroll
                    for (int n = 0; n < 2; ++n) *(f32x4*)(rowp + bj * HALF + n * 16) = acc[ai][bj][m][n] * s; }
    }
};
struct EpiF32Res {
    static constexpr bool PERM = false, AFTER_DRAIN = false;
    int ldc; long rdelta; float alpha;
    __device__ __forceinline__ void operator()(const f32x4 (&acc)[2][2][4][2], const Unit& u, int wr, int wc, int fr, int fq) const {
        float* base = (float*)u.C + (wr * 64 + fr) * (size_t)ldc + wc * 32 + 4 * fq;
#pragma unroll
        for (int ai = 0; ai < 2; ++ai)
#pragma unroll
            for (int m = 0; m < 4; ++m) { float* rowp = base + (size_t)(ai * HALF + m * 16) * ldc;
#pragma unroll
                for (int bj = 0; bj < 2; ++bj)
#pragma unroll
                    for (int n = 0; n < 2; ++n) { float* p = rowp + bj * HALF + n * 16; f32x4 v = acc[ai][bj][m][n];
                        if (alpha != 0.f) { const f32x4 r = *(const f32x4*)((const char*)p + rdelta); v = v + r * alpha; }
                        *(f32x4*)p = v; } }
    }
};

template <class Epi, class Sched, bool ALIGN_EPI = false, bool SP2 = false, bool FP8 = false>
__device__ __forceinline__ void gemm_phase(PG8_LAS unsigned char* lds, const int wid  , const int K, const int lda, const int ldb, const Sched& S, const Epi& E) {
    const int lane = lane_id(), tid = wid * 64 + lane, wr = wid >> 2, wc = wid & 3, fr = lane & 15, fq = lane >> 4;
    const int nt = K / BK;
    unsigned voffA[2], voffB[2];
#pragma unroll
    for (int i = 0; i < 2; ++i) { int R, C; stage_rc(tid * 16 + i * 8192, R, C); const int Rb = Epi::PERM ? ((R & ~31) + perm32(R & 31)) : R;
        voffA[i] = (unsigned)(R * lda + C) * 2u; voffB[i] = (unsigned)(Rb * ldb + C) * 2u; }
    const size_t kstep = (size_t)(BK * 2);
    const size_t hstepA = (size_t)HALF * lda * 2, hstepB = (size_t)HALF * ldb * 2;
    const unsigned ldsw = (unsigned)wid * 1024u;
    const unsigned ldsbase = (unsigned)__builtin_amdgcn_readfirstlane((int)((unsigned)(uintptr_t)lds + ldsw));
    const int aoff = lds_byte(wr * 64 + fr, fq * 8), boff = lds_byte(wc * 32 + fr, fq * 8);
#define PG8_SA(b, h) (((b) * 2 + (h)) * HTB)
#define PG8_SB(b, h) ((4 + (b) * 2 + (h)) * HTB)
#define PG8_STAGE(bufoff, gbase, voff) do { _Pragma("unroll") for (int _i = 0; _i < 2; ++_i) { \
        if constexpr (FP8) { unsigned _keep; const unsigned long long _g0 = (unsigned long long)(uintptr_t)(gbase); const char* _gb = (const char*)(uintptr_t)(((unsigned long long)(unsigned)__builtin_amdgcn_readfirstlane((int)(_g0 >> 32)) << 32) | (unsigned)__builtin_amdgcn_readfirstlane((int)_g0)); const unsigned _la = ldsbase + (unsigned)((bufoff) + _i * 8192);     \
            asm volatile("s_mov_b32 %0, m0\n\ts_mov_b32 m0, %3\n\ts_nop 0\n\tglobal_load_lds_dwordx4 %1, %2\n\ts_mov_b32 m0, %0" : "=&s"(_keep) : "v"((voff)[_i]), "s"(_gb), "s"(_la) : "memory"); } \
        else __builtin_amdgcn_global_load_lds((const unsigned*)((const char*)(gbase) + (voff)[_i]), (PG8_LAS unsigned*)(lds + (bufoff) + ldsw + _i * 8192), 16, 0, 0); } } while (0)
#define PG8_LDA(dst, b, h) do { _Pragma("unroll") for (int m = 0; m < 4; ++m) { if constexpr (FP8) { \
        const v4i_t _l = *(const PG8_LAS v4i_t*)(lds + PG8_SA(b, h) + aoff + m * 2048), _h = *(const PG8_LAS v4i_t*)(lds + PG8_SA(b, h) + aoff + m * 2048 + 1024); dst##8[m] = __builtin_shufflevector(_l, _h, 0, 1, 2, 3, 4, 5, 6, 7); } \
        else { _Pragma("unroll") for (int k = 0; k < 2; ++k) dst[m][k] = *(const PG8_LAS bf16x8*)(lds + PG8_SA(b, h) + aoff + m * 2048 + k * 1024); } } } while (0)
#define PG8_LDB(dst, b, h) do { _Pragma("unroll") for (int n = 0; n < 2; ++n) { if constexpr (FP8) { \
        const v4i_t _l = *(const PG8_LAS v4i_t*)(lds + PG8_SB(b, h) + boff + n * 2048), _h = *(const PG8_LAS v4i_t*)(lds + PG8_SB(b, h) + boff + n * 2048 + 1024); dst##8[n] = __builtin_shufflevector(_l, _h, 0, 1, 2, 3, 4, 5, 6, 7); } \
        else { _Pragma("unroll") for (int k = 0; k < 2; ++k) dst[n][k] = *(const PG8_LAS bf16x8*)(lds + PG8_SB(b, h) + boff + n * 2048 + k * 1024); } } } while (0)
#define PG8_CAT8(lo, hi) __builtin_shufflevector(__builtin_bit_cast(v4i_t, lo), __builtin_bit_cast(v4i_t, hi), 0, 1, 2, 3, 4, 5, 6, 7)
#define PG8_MMA(ai, bj, At, Bt) do { __builtin_amdgcn_s_setprio(1); \
        if constexpr (FP8) { _Pragma("unroll") for (int m = 0; m < 4; ++m) _Pragma("unroll") for (int n = 0; n < 2; ++n) \
            acc[ai][bj][m][n] = __builtin_amdgcn_mfma_scale_f32_16x16x128_f8f6f4(Bt##8[n], At##8[m], acc[ai][bj][m][n], 0, 0, 0, 0, 0, 0); } \
        else { _Pragma("unroll") for (int m = 0; m < 4; ++m) _Pragma("unroll") for (int n = 0; n < 2; ++n) _Pragma("unroll") for (int k = 0; k < 2; ++k) \
            acc[ai][bj][m][n] = __builtin_amdgcn_mfma_f32_16x16x32_bf16(Bt[n][k], At[m][k], acc[ai][bj][m][n], 0, 0, 0); } \
        __builtin_amdgcn_s_setprio(0); } while (0)
#define PG8_WAIT_V(n) asm volatile("s_waitcnt vmcnt(" #n ")" ::: "memory")
#define PG8_WAIT_L(n) asm volatile("s_waitcnt lgkmcnt(" #n ")" ::: "memory")
#define PG8_BAR __builtin_amdgcn_s_barrier()
#define PG8_SCHED __builtin_amdgcn_sched_barrier(0)
    Unit cur, nxt; int ui = 0;
    if (!S.next(0, cur)) return;
    f32x4 acc[2][2][4][2];
#pragma unroll
    for (int a = 0; a < 2; ++a)
#pragma unroll
        for (int b = 0; b < 2; ++b)
#pragma unroll
            for (int m = 0; m < 4; ++m)
#pragma unroll
                for (int n = 0; n < 2; ++n) acc[a][b][m][n] = (f32x4){0.f, 0.f, 0.f, 0.f};
    bf16x8 At[4][2], B0[2][2], B1[2][2]; v8i_t At8[4], B08[2], B18[2];
    const char* cA = cur.A; const char* cB = cur.B;
    S.a_ready(cur);
    if constexpr (SP2) {
        PG8_STAGE(PG8_SB(0, 0), cB, voffB); PG8_STAGE(PG8_SB(0, 1), cB + hstepB, voffB); PG8_STAGE(PG8_SA(0, 0), cA, voffA); PG8_STAGE(PG8_SA(0, 1), cA + hstepA, voffA);
        if (wr == 1) PG8_BAR;
        PG8_WAIT_V(2); PG8_BAR;
        PG8_STAGE(PG8_SB(1, 0), cB + kstep, voffB); PG8_STAGE(PG8_SA(1, 0), cA + kstep, voffA); PG8_STAGE(PG8_SB(1, 1), cB + hstepB + kstep, voffB);
        PG8_WAIT_V(6); PG8_BAR;
    } else {
        PG8_STAGE(PG8_SB(0, 0), cB, voffB); PG8_STAGE(PG8_SA(0, 0), cA, voffA); PG8_STAGE(PG8_SB(0, 1), cB + hstepB, voffB); PG8_STAGE(PG8_SA(0, 1), cA + hstepA, voffA);
        if (wr == 1) PG8_BAR;
        PG8_WAIT_V(4); PG8_BAR;
        PG8_STAGE(PG8_SB(1, 0), cB + kstep, voffB); PG8_STAGE(PG8_SA(1, 0), cA + kstep, voffA); PG8_STAGE(PG8_SB(1, 1), cB + hstepB + kstep, voffB);
        PG8_WAIT_V(6); PG8_BAR;
    }
    for (;;) {
        const bool has_next = S.next(ui + 1, nxt);
        const char* nA = has_next ? nxt.A : cA; const char* nB = has_next ? nxt.B : cB;
#pragma unroll 1
        for (int t = 0; t < nt; t += 2) {
            const bool last = (t == nt - 2);
            const char* a1 = cA + (size_t)(t + 1) * kstep;
            const char* a2 = last ? nA : cA + (size_t)(t + 2) * kstep; const char* b2 = last ? nB : cB + (size_t)(t + 2) * kstep;
            const char* a3 = a2 + kstep; const char* b3 = b2 + kstep;
            if (last && has_next) S.a_ready(nxt);
            if constexpr (SP2) {
            PG8_LDB(B0, 0, 0); PG8_LDB(B1, 0, 1); PG8_SCHED; PG8_LDA(At, 0, 0); PG8_STAGE(PG8_SA(1, 1), a1 + hstepA, voffA);
            PG8_WAIT_V(8); PG8_WAIT_L(0); PG8_BAR; PG8_MMA(0, 0, At, B0); PG8_MMA(0, 1, At, B1); PG8_BAR; PG8_SCHED;
            PG8_LDA(At, 0, 1); PG8_STAGE(PG8_SB(0, 0), b2, voffB); PG8_STAGE(PG8_SB(0, 1), b2 + hstepB, voffB); PG8_STAGE(PG8_SA(0, 0), a2, voffA);
            PG8_WAIT_V(8); PG8_WAIT_L(0); PG8_BAR; PG8_MMA(1, 0, At, B0); PG8_MMA(1, 1, At, B1); PG8_BAR; PG8_SCHED;
            PG8_LDB(B0, 1, 0); PG8_LDB(B1, 1, 1); PG8_SCHED; PG8_LDA(At, 1, 0); PG8_STAGE(PG8_SA(0, 1), a2 + hstepA, voffA);
            PG8_WAIT_V(8); PG8_WAIT_L(0); PG8_BAR; PG8_MMA(0, 0, At, B0); PG8_MMA(0, 1, At, B1); PG8_BAR; PG8_SCHED;
            PG8_LDA(At, 1, 1); PG8_STAGE(PG8_SB(1, 0), b3, voffB); PG8_STAGE(PG8_SB(1, 1), b3 + hstepB, voffB); PG8_STAGE(PG8_SA(1, 0), a3, voffA);
            PG8_WAIT_V(8); PG8_WAIT_L(0); PG8_BAR; PG8_MMA(1, 0, At, B0); PG8_MMA(1, 1, At, B1); PG8_BAR; PG8_SCHED;
            } else {
            PG8_LDB(B0, 0, 0); PG8_SCHED; PG8_LDA(At, 0, 0); PG8_STAGE(PG8_SA(1, 1), a1 + hstepA, voffA);
            PG8_WAIT_L(8); PG8_BAR; PG8_WAIT_L(0); PG8_MMA(0, 0, At, B0); PG8_BAR; PG8_SCHED;
            PG8_LDB(B1, 0, 1); PG8_STAGE(PG8_SB(0, 0), b2, voffB);
            PG8_BAR; PG8_WAIT_L(0); PG8_MMA(0, 1, At, B1); PG8_BAR;
            PG8_LDA(At, 0, 1); PG8_STAGE(PG8_SA(0, 0), a2, voffA);
            PG8_BAR; PG8_WAIT_L(0); PG8_MMA(1, 0, At, B0); PG8_BAR; PG8_SCHED;
            PG8_STAGE(PG8_SB(0, 1), b2 + hstepB, voffB);
            PG8_WAIT_V(6); PG8_BAR; PG8_MMA(1, 1, At, B1); PG8_BAR;
            PG8_LDB(B0, 1, 0); PG8_SCHED; PG8_LDA(At, 1, 0); PG8_STAGE(PG8_SA(0, 1), a2 + hstepA, voffA);
            PG8_WAIT_L(8); PG8_BAR; PG8_WAIT_L(0); PG8_MMA(0, 0, At, B0); PG8_BAR; PG8_SCHED;
            PG8_LDB(B1, 1, 1); PG8_STAGE(PG8_SB(1, 0), b3, voffB);
            PG8_BAR; PG8_WAIT_L(0); PG8_MMA(0, 1, At, B1); PG8_BAR;
            PG8_LDA(At, 1, 1); PG8_STAGE(PG8_SA(1, 0), a3, voffA);
            PG8_BAR; PG8_WAIT_L(0); PG8_MMA(1, 0, At, B0); PG8_BAR; PG8_SCHED;
            PG8_STAGE(PG8_SB(1, 1), b3 + hstepB, voffB);
            PG8_WAIT_V(6); PG8_BAR; PG8_MMA(1, 1, At, B1); PG8_BAR;
            }
        }
        if constexpr (ALIGN_EPI) { if (wr == 0) PG8_BAR; }
        if constexpr (!Epi::AFTER_DRAIN) { E(acc, cur, wr, wc, fr, fq); S.done(cur); }
        if (!has_next) break;
#pragma unroll
        for (int a = 0; a < 2; ++a)
#pragma unroll
            for (int b = 0; b < 2; ++b)
#pragma unroll
                for (int m = 0; m < 4; ++m)
#pragma unroll
                    for (int n = 0; n < 2; ++n) acc[a][b][m][n] = (f32x4){0.f, 0.f, 0.f, 0.f};
        cur = nxt; cA = nA; cB = nB; ++ui;
        if constexpr (ALIGN_EPI) { if (wr == 1) PG8_BAR; }
    }
    PG8_WAIT_V(0);
    if constexpr (!ALIGN_EPI) { if (wr == 0) PG8_BAR; }
    PG8_BAR;
    if constexpr (Epi::AFTER_DRAIN) { E.fused(acc, cur, wr, wc, fr, fq, lds, wid, lane); S.done(cur); }
#undef PG8_SA
#undef PG8_SB
#undef PG8_STAGE
#undef PG8_LDA
#undef PG8_LDB
#undef PG8_MMA
#undef PG8_CAT8
#undef PG8_WAIT_V
#undef PG8_WAIT_L
#undef PG8_BAR
#undef PG8_SCHED
}
}

namespace att {
struct HalfUnit {
    const bf16* Q; long qs;
    const bf16* K; const bf16* V; long ks;
    int kc0, L, qc0, band;
    float c2;
    bf16* O; long os;
    float* lse; long ls;
    int mask;
};
#define KSWZ(row, colB) ((row) * 256 + ((colB) ^ (((row) & 7) << 4)))
__device__ __forceinline__ int crow(int r, int hi) { return (r & 3) + 8 * (r >> 2) + 4 * hi; }
__device__ __forceinline__ int v_st(int k, int c) { const int kk = (k & ~0xC) | ((k & 4) << 1) | ((k & 8) >> 1); return ((kk >> 3) * 4 + (c >> 5)) * 512 + ((kk & 7) * 32 + (c & 31)) * 2; }
__device__ __forceinline__ int v_rd_base(int lane) { return ((lane & 3) << 3) | (((lane >> 2) & 3) << 6) | (((lane >> 4) & 1) << 5) | (((lane >> 5) & 1) << 8); }
constexpr int v_rd_off(int d0, int ks, int half) { return d0 * 512 + ks * 4096 + half * 2048; }
template <int OFF> __device__ __forceinline__ s16x4 tr_read(int vb) {
    s16x4 r; asm volatile("ds_read_b64_tr_b16 %0, %1 offset:%2" : "=&v"(r) : "v"(vb), "i"(OFF) : "memory"); return r;
}
template <int D0> __device__ __forceinline__ void pv_one(f32x16& od, int vb, bf16x8 pa0, bf16x8 pa1, bf16x8 pa2, bf16x8 pa3) {
    const s16x4 l0 = tr_read<v_rd_off(D0, 0, 0)>(vb), h0 = tr_read<v_rd_off(D0, 0, 1)>(vb), l1 = tr_read<v_rd_off(D0, 1, 0)>(vb), h1 = tr_read<v_rd_off(D0, 1, 1)>(vb);
    const s16x4 l2 = tr_read<v_rd_off(D0, 2, 0)>(vb), h2 = tr_read<v_rd_off(D0, 2, 1)>(vb), l3 = tr_read<v_rd_off(D0, 3, 0)>(vb), h3 = tr_read<v_rd_off(D0, 3, 1)>(vb);
    asm volatile("s_waitcnt lgkmcnt(0)" ::: "memory"); __builtin_amdgcn_sched_barrier(0);
#define PK(L, H) (bf16x8){L[0], L[1], L[2], L[3], H[0], H[1], H[2], H[3]}
    od = __builtin_amdgcn_mfma_f32_32x32x16_bf16(pa0, PK(l0, h0), od, 0, 0, 0);
    od = __builtin_amdgcn_mfma_f32_32x32x16_bf16(pa1, PK(l1, h1), od, 0, 0, 0);
    od = __builtin_amdgcn_mfma_f32_32x32x16_bf16(pa2, PK(l2, h2), od, 0, 0, 0);
    od = __builtin_amdgcn_mfma_f32_32x32x16_bf16(pa3, PK(l3, h3), od, 0, 0, 0);
#undef PK
}
__device__ __forceinline__ void qkt(f32x16& p0, f32x16& p1, const LAS char* Ks, const bf16x8 (&qr)[8], int r32, int hi) {
    p0 = f32x16{}; p1 = f32x16{};
#pragma unroll
    for (int d0 = 0; d0 < 8; ++d0) { const int cb = (d0 * 16 + hi * 8) * 2;
        const bf16x8 b0 = *(const LAS bf16x8*)(Ks + KSWZ(r32, cb));
        const bf16x8 b1 = *(const LAS bf16x8*)(Ks + KSWZ(32 + r32, cb));
        p0 = __builtin_amdgcn_mfma_f32_32x32x16_bf16(b0, qr[d0], p0, 0, 0, 0);
        p1 = __builtin_amdgcn_mfma_f32_32x32x16_bf16(b1, qr[d0], p1, 0, 0, 0); }
}

__device__ __forceinline__ void attn_pair(LAS char* lds, const int wave, const HalfUnit& u) {
    const int lane = lane_id(), r32 = lane & 31, hi = lane >> 5;
    const int hw = wave >> 2, w4 = wave & 3;
    LAS char* Kb = lds + hw * 65536; LAS char* Vb = Kb + 32768;
    LAS float* al_l = (LAS float*)(lds + 131072 + wave * 256); LAS float* li_l = al_l + 32;
    bf16x8 qr[8];
    { const bf16* qp = u.Q + (long)(w4 * 32 + r32) * u.qs + hi * 8;
#pragma unroll
      for (int d0 = 0; d0 < 8; ++d0) qr[d0] = *(const bf16x8*)(qp + d0 * 16); }
    unsigned offK[4], offV[4];
#pragma unroll
    for (int j = 0; j < 4; ++j) { const int q = (4 * j + w4) * 64 + lane;
        { const int row = q >> 4, slot = q & 15, chunk = slot ^ (row & 7); offK[j] = (unsigned)(row * (int)u.ks + chunk * 8) * 2u; }
        { const int sub = q >> 5, kk = (sub >> 2) * 8 + ((q & 31) >> 2), c8 = (sub & 3) * 4 + (q & 3); const int k = (kk & ~0xC) | ((kk & 4) << 1) | ((kk & 8) >> 1);
          offV[j] = (unsigned)(k * (int)u.ks + c8 * 8) * 2u; } }
#define ALOAD(kc, b) do { const char* kg = (const char*)(u.K + (long)(kc) * u.ks); const char* vg = (const char*)(u.V + (long)(kc) * u.ks); \
    _Pragma("unroll") for (int j = 0; j < 4; ++j) { \
        __builtin_amdgcn_global_load_lds((const unsigned*)(kg + offK[j]), (LAS unsigned*)(Kb + (b) * 16384 + (4 * j + w4) * 1024), 16, 0, 0); \
        __builtin_amdgcn_global_load_lds((const unsigned*)(vg + offV[j]), (LAS unsigned*)(Vb + (b) * 16384 + (4 * j + w4) * 1024), 16, 0, 0); } } while (0)
    float m_reg = -1e30f, l_reg = 0.f; f32x16 o[4] = {};
    const int qa = u.qc0 + 32 * w4;
    const float bandf = (float)u.band, c2 = u.c2;
    const bool tv0 = (u.kc0 >= 0 && u.kc0 < u.L);
    if (tv0) ALOAD(u.kc0, 0);
    asm volatile("s_waitcnt vmcnt(0)" ::: "memory");
    __syncthreads();
#pragma unroll 1
    for (int t = 0; t < 4; ++t) {
        const int kc = u.kc0 + 64 * t, kcn = kc + 64;
        const bool tv = (kc >= 0 && kc < u.L), tvn = (t < 3) && (kcn >= 0 && kcn < u.L);
        if (tvn) ALOAD(kcn, (t + 1) & 1);
        const bool act = tv && (kc <= qa + 31 + u.band) && (kc + 63 >= qa - u.band);
        if (act) {
            const int b = t & 1;
            f32x16 p0, p1;
            qkt(p0, p1, Kb + b * 16384, qr, r32, hi);
            constexpr float C1 = SCALE * LOG2E;
            float tmax = -1e30f;
            if (u.mask) {
                const float dbf = (float)(kc - qa - r32 + 4 * hi);
#pragma unroll
                for (int r = 0; r < 16; ++r) { const float d0 = fabsf(dbf + (float)((r & 3) + 8 * (r >> 2))), d1 = fabsf(dbf + (float)(32 + (r & 3) + 8 * (r >> 2)));
                    const float t0 = d0 <= bandf ? fmaf(-c2, d0, p0[r] * C1) : -1e30f, t1 = d1 <= bandf ? fmaf(-c2, d1, p1[r] * C1) : -1e30f;
                    p0[r] = t0; p1[r] = t1; tmax = fmaxf(tmax, fmaxf(t0, t1)); }
            } else {
#pragma unroll
                for (int r = 0; r < 16; ++r) { p0[r] *= C1; p1[r] *= C1; tmax = fmaxf(tmax, fmaxf(p0[r], p1[r])); }
            }
            { auto rr = __builtin_amdgcn_permlane32_swap(__float_as_uint(tmax), __float_as_uint(tmax), false, false);
              tmax = fmaxf(__uint_as_float(rr[0]), __uint_as_float(rr[1])); }
            const float mn = fmaxf(m_reg, tmax), alpha = __builtin_amdgcn_exp2f(m_reg - mn); m_reg = mn;
            float ps = 0.f;
#pragma unroll
            for (int r = 0; r < 16; ++r) { float e0 = __builtin_amdgcn_exp2f(p0[r] - mn), e1 = __builtin_amdgcn_exp2f(p1[r] - mn);
                e0 = p0[r] > -1e29f ? e0 : 0.f; e1 = p1[r] > -1e29f ? e1 : 0.f; p0[r] = e0; p1[r] = e1; ps += e0 + e1; }
            { auto rr = __builtin_amdgcn_permlane32_swap(__float_as_uint(ps), __float_as_uint(ps), false, false);
              ps = __uint_as_float(rr[0]) + __uint_as_float(rr[1]); }
            l_reg = l_reg * alpha + ps;
            if (__any(alpha < 1.f)) { if (hi == 0) al_l[r32] = alpha; asm volatile("s_waitcnt lgkmcnt(0)" ::: "memory");
#pragma unroll
                for (int r = 0; r < 16; ++r) { const float a = al_l[crow(r, hi)];
#pragma unroll
                    for (int d = 0; d < 4; ++d) o[d][r] *= a; }
                asm volatile("s_waitcnt lgkmcnt(0)" ::: "memory"); }
            bf16x8 pa0, pa1, pa2, pa3;
#define PK4(P, BASE, OUT) do { unsigned a0 = cvt_pk_bf16(P[BASE + 0], P[BASE + 1]), a1 = cvt_pk_bf16(P[BASE + 2], P[BASE + 3]);   \
    unsigned b0 = cvt_pk_bf16(P[BASE + 4], P[BASE + 5]), b1 = cvt_pk_bf16(P[BASE + 6], P[BASE + 7]);                              \
    auto r0 = __builtin_amdgcn_permlane32_swap(a0, b0, false, false); auto r1 = __builtin_amdgcn_permlane32_swap(a1, b1, false, false); \
    v4u w = {r0[0], r1[0], r0[1], r1[1]}; OUT = *reinterpret_cast<bf16x8*>(&w); } while (0)
            PK4(p0, 0, pa0); PK4(p0, 8, pa1); PK4(p1, 0, pa2); PK4(p1, 8, pa3);
#undef PK4
            const int vb = (int)(unsigned)(uintptr_t)(Vb + b * 16384) + v_rd_base(lane);
            pv_one<0>(o[0], vb, pa0, pa1, pa2, pa3); pv_one<1>(o[1], vb, pa0, pa1, pa2, pa3); pv_one<2>(o[2], vb, pa0, pa1, pa2, pa3); pv_one<3>(o[3], vb, pa0, pa1, pa2, pa3);
        }
        asm volatile("s_waitcnt vmcnt(0)" ::: "memory");
        __syncthreads();
    }
    if (hi == 0) li_l[r32] = l_reg; asm volatile("s_waitcnt lgkmcnt(0)" ::: "memory");
    bf16* Ow = u.O + (long)(w4 * 32) * u.os + r32;
#pragma unroll
    for (int r = 0; r < 16; ++r) { const int orow = crow(r, hi); const float rl = __builtin_amdgcn_rcpf(li_l[orow]);
#pragma unroll
        for (int d0 = 0; d0 < 4; ++d0) { const float v = o[d0][r] * rl; Ow[(long)orow * u.os + d0 * 32] = (bf16)(cvt_pk_bf16(v, v) & 0xffffu); } }
    if (u.lse != nullptr && hi == 0) u.lse[(long)(w4 * 32 + r32) * u.ls] = (m_reg + __builtin_amdgcn_logf(l_reg)) * LN2;
    asm volatile("s_waitcnt lgkmcnt(0)" ::: "memory");
    __syncthreads();
#undef ALOAD
}
}

constexpr int NWAVES = 8;
constexpr size_t MiB = 1u << 20;
constexpr int LDS_BYTES = 147456;
constexpr int LDS_MISC = 131072 + 2048;
constexpr size_t WS_CTL = 0, CTL_ZERO_BYTES = 64 * 1024;
constexpr size_t WS_WIN_A = 2 * MiB, WS_WKV_A = 12 * MiB, WS_WOUT_A = 14 * MiB, WS_WGU_A = 16 * MiB, WS_WDN_A = 27 * MiB;
constexpr size_t WS_XB = 34 * MiB, WS_MEMB = 66 * MiB, WS_KV_A = 70 * MiB, WS_PROJ0 = 74 * MiB, WS_OG = 234 * MiB, WS_LSE = 282 * MiB, WS_MIX = 283 * MiB;
constexpr size_t WS_X1 = 74 * MiB, WS_X1B = 138 * MiB, WS_H = 170 * MiB;
constexpr size_t WS_X2 = 300 * MiB, WS_X2B = 364 * MiB, WS_PROJ1 = 170 * MiB, WS_U = 202 * MiB, WS_ACS = 218 * MiB, WS_MIX1 = 250 * MiB;
constexpr size_t WS_CS = 400 * MiB, WS_TME = 416 * MiB, WS_TMO = 416 * MiB + 512 * 1024, WS_WIN_B = 417 * MiB, WS_WOUT_B = 419 * MiB, WS_WKV_B = 421 * MiB, WS_KV_B = 423 * MiB;
constexpr size_t WS_TSLOT = 1 * MiB, WS_GATES = 1 * MiB + 256 * 1024, WS_WDN_M = 2 * MiB, WS_WGU_M = 58 * MiB, WS_XS = 170 * MiB, WS_HM = 238 * MiB, WS_Y = 58 * MiB;
constexpr int CW_CNT = 8192, CW_CONV = 8256;
constexpr size_t WS_NEED = 476 * MiB;
constexpr int CW_BAR = 1024;

#define XB_TMO      128
#define XB_XCNT(j)  (256  + 64 * (j))
#define XB_XSUB(j)  (1280 + 64 * (j))
#define XB_XGEN(j)  (2304 + 64 * (j))
#define XB_TOP      3328
#define XB_TOPGEN   3392
#define XCD_BAR_WORDS 3456
#define XB_SPIN_CAP (1u << 18)
__device__ __forceinline__ unsigned xb_ld(unsigned* p)              { return __hip_atomic_load(p, __ATOMIC_RELAXED, __HIP_MEMORY_SCOPE_AGENT); }
__device__ __forceinline__ unsigned xb_add(unsigned* p, unsigned v) { return __hip_atomic_fetch_add(p, v, __ATOMIC_RELAXED, __HIP_MEMORY_SCOPE_AGENT); }
__device__ __forceinline__ unsigned xb_xcc_id() { return (unsigned)__builtin_amdgcn_s_getreg((3 << 11) | 20) & 0xFu; }
#define XB_SPIN(cond, bar) do { unsigned _sp = 0; while (cond) { __builtin_amdgcn_s_sleep(1); \
    if ((++_sp & 255u) == 0u) { if (xb_ld(&(bar)[XB_TMO])) break; if (_sp > XB_SPIN_CAP) { atomicAdd(&(bar)[XB_TMO], 1u); break; } } } } while (0)
struct XcdBarrier { unsigned* bar; unsigned x; volatile LAS unsigned* st; };
__device__ __forceinline__ XcdBarrier xcd_barrier_post(unsigned* bar, volatile LAS unsigned* st) {
    XcdBarrier b; b.bar = bar; b.x = xb_xcc_id(); b.st = st;
    if (threadIdx.x == 0) (void)xb_add(&bar[XB_XCNT(b.x)], 1u);
    return b;
}
__device__ __forceinline__ void xcd_barrier_complete(unsigned* bar, unsigned x, unsigned& nloc, unsigned& nx) {
    const unsigned G = gridDim.x * gridDim.y * gridDim.z;
    unsigned sum, cnt, mine, sp = 0u;
    for (;;) {
        sum = 0u; cnt = 0u; mine = 0u;
#pragma unroll
        for (unsigned j = 0; j < 16; ++j) { const unsigned c = xb_ld(&bar[XB_XCNT(j)]); sum += c; cnt += (c > 0u) ? 1u : 0u; mine = (j == x) ? c : mine; }
        if (sum == G) break;
        __builtin_amdgcn_s_sleep(1);
        if ((++sp & 255u) == 0u) { if (xb_ld(&bar[XB_TMO])) break; if (sp > XB_SPIN_CAP) { atomicAdd(&bar[XB_TMO], 1u); break; } }
    }
    nloc = mine > 0u ? mine : 1u; nx = cnt > 0u ? cnt : 1u;
}
__device__ __forceinline__ void xcd_barrier(const XcdBarrier& b) {
    asm volatile("s_waitcnt vmcnt(0)" ::: "memory");
    __syncthreads();
    if (threadIdx.x == 0) {
        unsigned* bar = b.bar;
        __builtin_amdgcn_s_waitcnt(0);
        unsigned nloc = b.st[0], nx = b.st[1];
        if (nloc == 0u) { xcd_barrier_complete(bar, b.x, nloc, nx); b.st[0] = nloc; b.st[1] = nx; }
        const unsigned old = xb_add(&bar[XB_XSUB(b.x)], 1u);
        const unsigned gen = old / nloc;
        if (old + 1u == (gen + 1u) * nloc) {
            __builtin_amdgcn_fence(__ATOMIC_RELEASE, "agent");
            asm volatile("s_waitcnt vmcnt(0)" ::: "memory");
            const unsigned og = xb_add(&bar[XB_TOP], 1u);
            const unsigned tg = og / nx;
            if (og + 1u == (tg + 1u) * nx) xb_add(&bar[XB_TOPGEN], 1u);
            else XB_SPIN(xb_ld(&bar[XB_TOPGEN]) == tg, bar);
            __builtin_amdgcn_fence(__ATOMIC_ACQUIRE, "agent");
            xb_add(&bar[XB_XGEN(b.x)], 1u);
            asm volatile("s_waitcnt vmcnt(0)" ::: "memory");
        } else {
            XB_SPIN(xb_ld(&bar[XB_XGEN(b.x)]) == gen, bar);
            __builtin_amdgcn_fence(__ATOMIC_ACQUIRE, "agent");
            asm volatile("s_waitcnt vmcnt(0)" ::: "memory");
        }
    }
    __syncthreads();
}

struct Args { const float* in[25]; float* out; unsigned char* ws; int ph_lo, ph_hi; };

template <bool F8>
__device__ __forceinline__ void conv_item(const float* __restrict__ W, int K, int N, void* __restrict__ WT, int mode, int row_off, float scale, int item, int lane) {
    const int nblk = N / 64, kb = item / nblk, nb = item - kb * nblk, k0 = 64 * kb, n0 = 64 * nb;
    const float* src = W + (size_t)k0 * N + n0 + lane;
    float v[64];
#pragma unroll
    for (int i = 0; i < 64; ++i) v[i] = __builtin_nontemporal_load(src + (size_t)i * N);
    const int ng = n0 + lane; const int dr = mode == 0 ? row_off + ng : (ng >> 7) * 256 + (ng & 127) + row_off;
    if constexpr (F8) {
        unsigned char* d = (unsigned char*)WT + (size_t)dr * K + k0;
#pragma unroll
        for (int c = 0; c < 4; ++c) { v4u o;
#pragma unroll
            for (int q = 0; q < 4; ++q) { int w = 0; w = __builtin_amdgcn_cvt_pk_fp8_f32(v[16 * c + 4 * q] * scale, v[16 * c + 4 * q + 1] * scale, w, false);
                w = __builtin_amdgcn_cvt_pk_fp8_f32(v[16 * c + 4 * q + 2] * scale, v[16 * c + 4 * q + 3] * scale, w, true); o[q] = (unsigned)w; }
            *(v4u*)(d + 16 * c) = o; }
    } else {
        bf16* d = (bf16*)WT + (size_t)dr * K + k0;
#pragma unroll
        for (int c = 0; c < 8; ++c) { v4u o; o.x = cvt_pk_bf16(v[8 * c], v[8 * c + 1]); o.y = cvt_pk_bf16(v[8 * c + 2], v[8 * c + 3]); o.z = cvt_pk_bf16(v[8 * c + 4], v[8 * c + 5]); o.w = cvt_pk_bf16(v[8 * c + 6], v[8 * c + 7]);
            *(v4u*)(d + 8 * c) = o; }
    }
}
__device__ __forceinline__ void cvt_rows(const float* __restrict__ src, bf16* __restrict__ dst, size_t n8, size_t i0, size_t stride) {
    for (size_t i = i0; i < n8; i += stride) { const f32x4 a = *(const f32x4*)(src + i * 8), b = *(const f32x4*)(src + i * 8 + 4);
        v4u o; o.x = cvt_pk_bf16(a[0], a[1]); o.y = cvt_pk_bf16(a[2], a[3]); o.z = cvt_pk_bf16(b[0], b[1]); o.w = cvt_pk_bf16(b[2], b[3]); *(v4u*)(dst + i * 8) = o; }
}

struct P1Order {
    const char* xb; const char* win; char* proj; const char* memb; const char* wkv; char* kv; const char* wkv2; char* kv2; int G, c;
    __device__ __forceinline__ bool next(int i, pg8::Unit& u) const {
        const int L = i * G + c; int pm, pn;
        if (L < 1280) { pg8::tile_order(L, 64, 20, pm, pn); u.A = xb + (size_t)pm * 256 * D * 2; u.B = win + (size_t)pn * 256 * D * 2; u.C = proj + ((size_t)pm * 256 * PROJA + pn * 256) * 2; u.aux = 0; return true; }
        int l2 = L - 1280; if (l2 >= 64) return false;
        const bool second = l2 >= 32; l2 &= 31;
        pm = l2 >> 2; pn = l2 & 3; u.A = memb + (size_t)pm * 256 * D * 2; u.B = (second ? wkv2 : wkv) + (size_t)pn * 256 * D * 2; u.C = (second ? kv2 : kv) + ((size_t)pm * 256 * 1024 + pn * 256) * 2; u.aux = 1024; return true;
    }
    __device__ __forceinline__ void a_ready(const pg8::Unit&) const {}
    __device__ __forceinline__ void done(const pg8::Unit&) const {}
};
struct EpiBf16V {
    static constexpr bool PERM = true, AFTER_DRAIN = false;
    int ldc;
    __device__ __forceinline__ void operator()(const f32x4 (&acc)[2][2][4][2], const pg8::Unit& u, int wr, int wc, int fr, int fq) const {
        pg8::EpiBf16 e{u.aux ? u.aux : ldc, 128 * (u.aux ? u.aux : ldc), 1.f}; e(acc, u, wr, wc, fr, fq);
    }
};

struct ChanOrder {
    const char* tme; const char* tmo; const char* u; char* acs; int G, c;
    __device__ __forceinline__ bool next(int i, pg8::Unit& un) const {
        const int L = i * G + c; if (L >= 256) return false;
        const int g = L & 3, pn = L >> 2, b = pn >> 3, s0 = (pn & 7) * 256;
        un.A = tme + (size_t)(g & 1) * (WS_TMO - WS_TME); un.B = u + ((size_t)pn * 256 * 512 + (g & ~1) * 128) * 2; un.C = acs + (((size_t)b * 512 + g * 128) * 4096 + s0) * 2; un.aux = 0; return true;
    }
    __device__ __forceinline__ void a_ready(const pg8::Unit&) const {}
    __device__ __forceinline__ void done(const pg8::Unit&) const {}
};
struct SeqOrder {
    const char* cs; const char* acs; char* mix; int G, c;
    __device__ __forceinline__ bool next(int i, pg8::Unit& un) const {
        const int L = i * G + c; if (L >= 128) return false;
        const int b = L >> 4, pm = (L & 15) >> 1, pn = L & 1;
        un.A = cs + (size_t)pm * 256 * 4096 * 2; un.B = acs + ((size_t)b * 512 + pn * 256) * 4096 * 2; un.C = mix + (((size_t)b * SEQ + pm * 256) * D + pn * 256) * 2; un.aux = 0; return true;
    }
    __device__ __forceinline__ void a_ready(const pg8::Unit&) const {}
    __device__ __forceinline__ void done(const pg8::Unit&) const {}
};

struct MoeOrder {
    const char* A; const char* B; char* C; int G, c, nN, nRT; int t1, t2, t3, t4, t5, t6, t7; size_t aT, bE, bT, cTm, cTn;
    __device__ void init(const unsigned* cnt, const void* A_, int lda, const void* B_, int ldb, int nrows_e, void* C_, int ldc, int csz, int cw, int nN_, int G_, int c_) {
        int tp[9]; tp[0] = 0;
#pragma unroll
        for (int e = 0; e < 8; ++e) tp[e + 1] = tp[e] + (int)(((unsigned)__builtin_amdgcn_readfirstlane((int)__hip_atomic_load(cnt + e, __ATOMIC_RELAXED, __HIP_MEMORY_SCOPE_AGENT)) + 255u) >> 8);
        t1 = tp[1]; t2 = tp[2]; t3 = tp[3]; t4 = tp[4]; t5 = tp[5]; t6 = tp[6]; t7 = tp[7]; nRT = tp[8];
        A = (const char*)A_; B = (const char*)B_; C = (char*)C_; G = G_; c = c_; nN = nN_;
        aT = (size_t)256 * lda * 2; bE = (size_t)nrows_e * ldb * 2; bT = (size_t)256 * ldb * 2; cTm = (size_t)256 * ldc * csz; cTn = (size_t)cw * csz; }
    __device__ __forceinline__ bool next(int i, pg8::Unit& u) const { int rt, pn; if (!pg8::tile_order(i * G + c, nRT, nN, rt, pn)) return false;
        rt = __builtin_amdgcn_readfirstlane(rt); pn = __builtin_amdgcn_readfirstlane(pn);
        const int e = __builtin_amdgcn_readfirstlane((rt >= t1) + (rt >= t2) + (rt >= t3) + (rt >= t4) + (rt >= t5) + (rt >= t6) + (rt >= t7));
        u.A = A + rt * aT; u.B = B + e * bE + pn * bT; u.C = C + rt * cTm + pn * cTn; u.aux = 0; return true; }
    __device__ __forceinline__ void a_ready(const pg8::Unit&) const {}
    __device__ __forceinline__ void done(const pg8::Unit&) const {}
};

__device__ __forceinline__ att::HalfUnit make_half_unit(int hu, const bf16* proj, int ldp, int qmem_col, const bf16* kv, bf16* og, float* lse, bf16* mix, bool dilated_enabled) {
    att::HalfUnit u; const int kind = hu >> 9, idx = hu & 511;
    if (kind < 3) {
        const int g = kind, dil = g == 0 ? 1 : (g == 1 ? 4 : 16);
        int b, h, r, J;
        if (g == 0) { b = idx >> 6; h = (idx >> 4) & 3; r = 0; J = idx & 15; }
        else if (g == 1) { b = idx >> 6; h = (idx >> 4) & 3; r = (idx >> 2) & 3; J = idx & 3; }
        else { b = idx >> 6; h = (idx >> 4) & 3; r = idx & 15; J = 0; }
        const int hh = g * 4 + h; const long tok0 = (long)b * SEQ + r;
        const long tq = tok0 + (long)dil * 128 * J;
        u.Q = proj + tq * ldp + hh * HD; u.qs = (long)dil * ldp;
        u.K = proj + tok0 * ldp + 1536 + hh * HD; u.V = proj + tok0 * ldp + 3072 + hh * HD; u.ks = (long)dil * ldp;
        u.kc0 = 128 * J - 64; u.L = SEQ / dil; u.qc0 = 128 * J; u.band = 64;
        u.c2 = exp2f(-(float)(hh + 1) * (8.0f / 12.0f)) * (float)dil * LOG2E;
        u.O = og + (size_t)g * T * 512 + tq * 512 + h * HD; u.os = (long)dil * 512;
        u.lse = lse + (size_t)g * T * 4 + tq * 4 + h; u.ls = (long)dil * 4; u.mask = 1;
    } else {
        const int b = idx >> 6, h = (idx >> 4) & 3, J = idx & 15; const long tq = (long)b * SEQ + 128 * J;
        u.Q = proj + tq * ldp + qmem_col + h * HD; u.qs = ldp;
        u.K = kv + (long)b * NMEM * 1024 + h * HD; u.V = u.K + 512; u.ks = 1024;
        u.kc0 = 0; u.L = NMEM; u.qc0 = 0; u.band = 1 << 20; u.c2 = 0.f;
        u.O = mix + tq * D + 512 + h * HD; u.os = D; u.lse = nullptr; u.ls = 0; u.mask = 0;
    }
    (void)dilated_enabled;
    return u;
}

__device__ __forceinline__ void ln_rows(const float* in, const float* gam, const float* bet, float* of, bf16* ob, int gw, int NGW, int lane) {
    f32x4 gv[4], bv[4];
#pragma unroll
    for (int j = 0; j < 4; ++j) { gv[j] = *(const f32x4*)(gam + 4 * lane + 256 * j); bv[j] = *(const f32x4*)(bet + 4 * lane + 256 * j); }
    for (int m = gw; m < T; m += NGW) {
        const float* p = in + (size_t)m * D + 4 * lane;
        f32x4 v[4]; float s = 0.f;
#pragma unroll
        for (int j = 0; j < 4; ++j) { v[j] = *(const f32x4*)(p + 256 * j); s += (v[j][0] + v[j][1]) + (v[j][2] + v[j][3]); }
        const float mean = wave_sum(s) * (1.f / D); float q = 0.f;
#pragma unroll
        for (int j = 0; j < 4; ++j) { v[j] = v[j] - mean; q += (v[j][0] * v[j][0] + v[j][1] * v[j][1]) + (v[j][2] * v[j][2] + v[j][3] * v[j][3]); }
        const float rstd = rsqrtf(wave_sum(q) * (1.f / D) + LN_EPS);
#pragma unroll
        for (int j = 0; j < 4; ++j) { const f32x4 o = v[j] * rstd * gv[j] + bv[j];
            if (of) *(f32x4*)(of + (size_t)m * D + 4 * lane + 256 * j) = o;
            if (ob) { v2u w; w.x = cvt_pk_bf16(o[0], o[1]); w.y = cvt_pk_bf16(o[2], o[3]); *(v2u*)(ob + (size_t)m * D + 4 * lane + 256 * j) = w; } }
    }
}

__global__ void __launch_bounds__(NWAVES * 64, 2) mk_fwd(Args args) {
    extern __shared__ __attribute__((aligned(16))) unsigned char lds_raw[];
    LAS unsigned char* lds = (LAS unsigned char*)lds_raw;
    const int wave = __builtin_amdgcn_readfirstlane((int)(threadIdx.x >> 6));
#define lane (lane_id())
#define tid (wave * 64 + lane_id())
    const int G = gridDim.x; const int bx = blockIdx.x; const int vcu = (G % 8 == 0) ? (bx % 8) * (G / 8) + bx / 8 : bx;
    unsigned char* ws = args.ws;
    unsigned* ctl = (unsigned*)(ws + WS_CTL);
    volatile LAS unsigned* MISC = (volatile LAS unsigned*)(lds + LDS_MISC);
    for (int u = tid; u < (LDS_BYTES - LDS_MISC) / 4; u += NWAVES * 64) ((LAS unsigned*)(lds + LDS_MISC))[u] = 0u;
    __syncthreads();
    const int lo = args.ph_lo, hi = args.ph_hi;
    XcdBarrier bar; bar.bar = ctl + CW_BAR; bar.x = 0; bar.st = nullptr;
    if (hi - lo > 1) bar = xcd_barrier_post(ctl + CW_BAR, MISC + 8);
#define IN(k) (lo <= (k) && (k) < hi)
#define SEAM(k) do { if (IN(k) && IN((k) + 1)) xcd_barrier(bar); } while (0)
    const float* x = args.in[0]; const float* mem = args.in[1];
    bf16* Win_a = (bf16*)(ws + WS_WIN_A); bf16* Wkv_a = (bf16*)(ws + WS_WKV_A); bf16* Wout_a = (bf16*)(ws + WS_WOUT_A);
    bf16* Wgu_a = (bf16*)(ws + WS_WGU_A); bf16* Wdn_a = (bf16*)(ws + WS_WDN_A); float* x1 = (float*)(ws + WS_X1); bf16* x1b = (bf16*)(ws + WS_X1B); bf16* hb = (bf16*)(ws + WS_H);
    float* x2 = (float*)(ws + WS_X2); bf16* x2b = (bf16*)(ws + WS_X2B); bf16* proj1 = (bf16*)(ws + WS_PROJ1); bf16* ub = (bf16*)(ws + WS_U); bf16* ACS = (bf16*)(ws + WS_ACS); bf16* mix1 = (bf16*)(ws + WS_MIX1);
    bf16* CSm = (bf16*)(ws + WS_CS); bf16* TmE = (bf16*)(ws + WS_TME); bf16* TmO = (bf16*)(ws + WS_TMO); bf16* Win_b = (bf16*)(ws + WS_WIN_B); bf16* Wout_b = (bf16*)(ws + WS_WOUT_B); bf16* Wkv_b = (bf16*)(ws + WS_WKV_B); bf16* kv_b = (bf16*)(ws + WS_KV_B);
    unsigned* tslot = (unsigned*)(ws + WS_TSLOT); float* gates = (float*)(ws + WS_GATES); unsigned char* Wdn_m = ws + WS_WDN_M; unsigned char* Wgu_m = ws + WS_WGU_M; unsigned char* xs = ws + WS_XS; unsigned char* Hm = ws + WS_HM; float* Ym = (float*)(ws + WS_Y);
    unsigned* cnt = ctl + CW_CNT;
    bf16* xb = (bf16*)(ws + WS_XB); bf16* memb = (bf16*)(ws + WS_MEMB); bf16* kv_a = (bf16*)(ws + WS_KV_A); bf16* proj0 = (bf16*)(ws + WS_PROJ0);
    bf16* og = (bf16*)(ws + WS_OG); float* lse = (float*)(ws + WS_LSE); bf16* mix = (bf16*)(ws + WS_MIX);
    const int gw = vcu * NWAVES + wave, NGW = G * NWAVES;

    if (IN(0)) {
        constexpr int I_IN = (D / 64) * (PROJA / 64), I_SQ = (D / 64) * (D / 64);
        constexpr int I_GU = (D / 64) * (DFF / 64), I_DN = (DFF / 64) * (D / 64);
        constexpr int NITEMS = I_IN + 5 * I_SQ + 2 * I_GU + I_DN;
        for (int it = gw; it < NITEMS; it += NGW) {
            int r = it;
            if (r < I_IN) { conv_item<false>(args.in[2], D, PROJA, Win_a, 0, 0, 1.f, r, lane); continue; } r -= I_IN;
            if (r < I_SQ) { conv_item<false>(args.in[3], D, 1024, Wkv_a, 0, 0, 1.f, r, lane); continue; } r -= I_SQ;
            if (r < I_SQ) { conv_item<false>(args.in[4], D, D, Wout_a, 0, 0, 1.f, r, lane); continue; } r -= I_SQ;
            if (r < I_GU) { conv_item<false>(args.in[7], D, DFF, Wgu_a, 1, 0, 1.f, r, lane); continue; } r -= I_GU;
            if (r < I_GU) { conv_item<false>(args.in[8], D, DFF, Wgu_a, 1, 128, 1.f, r, lane); continue; } r -= I_GU;
            if (r < I_DN) { conv_item<false>(args.in[9], DFF, D, Wdn_a, 0, 0, 1.f, r, lane); continue; } r -= I_DN;
            if (r < I_SQ) { conv_item<false>(args.in[12], D, D, Win_b, 0, 0, 1.f, r, lane); continue; } r -= I_SQ;
            if (r < I_SQ) { conv_item<false>(args.in[14], D, D, Wkv_b, 0, 0, 1.f, r, lane); continue; } r -= I_SQ;
            conv_item<false>(args.in[15], D, D, Wout_b, 0, 0, 1.f, r, lane);
        }
        cvt_rows(x, xb, (size_t)T * D / 8, (size_t)bx * 512 + tid, (size_t)G * 512);
        for (size_t i = (size_t)bx * 512 + tid; i < (size_t)SEQ * 4096 / 2; i += (size_t)G * 512) { const int k = (int)(i / 2048), j = (int)(i % 2048) * 2, tt = j >> 11, s = j & 2047;
            const int i0 = (k * s) & 2047, i1 = (k * (s + 1)) & 2047; float a, b; if (tt == 0) { a = cospif(i0 * (1.f / 1024.f)); b = cospif(i1 * (1.f / 1024.f)); } else { a = -sinpif(i0 * (1.f / 1024.f)); b = -sinpif(i1 * (1.f / 1024.f)); }
            ((unsigned*)CSm)[i] = cvt_pk_bf16(a, b); }
        for (int i = bx * 512 + tid; i < 256 * 256; i += G * 512) { const int r = i >> 8, c = i & 255, tt = r >> 7, l = r & 127, cc = c & 127; const int ix = (l * cc) & 127;
            const float v = tt == 0 ? cospif(ix * (1.f / 64.f)) : sinpif(ix * (1.f / 64.f)); const bf16 vb = (bf16)(cvt_pk_bf16(v, v) & 0xffffu);
            TmE[i] = c < 128 ? vb : (bf16)0; TmO[i] = c < 128 ? (bf16)0 : vb; }
        cvt_rows(mem, memb, (size_t)BATCH * NMEM * D / 8, (size_t)bx * 512 + tid, (size_t)G * 512);
        __syncthreads();
    }
    SEAM(0);
    if (IN(1)) {
        P1Order S{(const char*)xb, (const char*)Win_a, (char*)proj0, (const char*)memb, (const char*)Wkv_a, (char*)kv_a, (const char*)Wkv_b, (char*)kv_b, G, bx};
        EpiBf16V E{PROJA};
        pg8::gemm_phase<EpiBf16V, P1Order, true, true>(lds, wave, D, D, D, S, E);
    }
    SEAM(1);
    if (IN(2)) {
        for (int p = bx; p < 1024; p += G) {
            const int hu = 2 * p + (wave >> 2);
            const att::HalfUnit u = make_half_unit(hu, proj0, PROJA, QKVW, kv_a, og, lse, mix, true);
            att::attn_pair((LAS char*)lds, wave, u);
        }
    }
    SEAM(2);
    if (IN(3)) {
        for (int tok = gw; tok < T; tok += NGW) {
            const int h = lane >> 4;
            const float l0 = lse[(size_t)tok * 4 + h], l1 = lse[(size_t)T * 4 + (size_t)tok * 4 + h], l2 = lse[(size_t)2 * T * 4 + (size_t)tok * 4 + h];
            const float M = fmaxf(fmaxf(l0, l1), l2);
            float w0 = __expf(l0 - M), w1 = __expf(l1 - M), w2 = __expf(l2 - M); const float wsum = 1.f / (w0 + w1 + w2); w0 *= wsum; w1 *= wsum; w2 *= wsum;
            const v4u a = *(const v4u*)(og + (size_t)tok * 512 + lane * 8), b = *(const v4u*)(og + (size_t)T * 512 + (size_t)tok * 512 + lane * 8), c = *(const v4u*)(og + (size_t)2 * T * 512 + (size_t)tok * 512 + lane * 8);
            v4u o;
#pragma unroll
            for (int j = 0; j < 4; ++j) { const float lo_ = w0 * __uint_as_float(a[j] << 16) + w1 * __uint_as_float(b[j] << 16) + w2 * __uint_as_float(c[j] << 16);
                const float hi_ = w0 * __uint_as_float(a[j] & 0xffff0000u) + w1 * __uint_as_float(b[j] & 0xffff0000u) + w2 * __uint_as_float(c[j] & 0xffff0000u);
                o[j] = cvt_pk_bf16(lo_, hi_); }
            *(v4u*)(mix + (size_t)tok * D + lane * 8) = o;
        }
    }
    SEAM(3);
    if (IN(4)) {
        pg8::PlainOrder S; S.init(mix, D, Wout_a, D, args.out, D, 4, 256, T, D, G, bx);
        pg8::EpiF32Res E{D, (long)((const char*)x - (const char*)args.out), ALPHA};
        pg8::gemm_phase<pg8::EpiF32Res, pg8::PlainOrder, true, true>(lds, wave, D, D, D, S, E);
    }
    SEAM(4);
    if (IN(5)) ln_rows(args.out, args.in[5], args.in[6], x1, x1b, gw, NGW, lane);
    SEAM(5);
    if (IN(6)) {
        pg8::PlainOrder S; S.init(x1b, D, Wgu_a, D, hb, DFF, 2, 128, T, 2 * DFF, G, bx);
        pg8::EpiSwiGLU E{DFF};
        pg8::gemm_phase<pg8::EpiSwiGLU, pg8::PlainOrder, true, true>(lds, wave, D, D, D, S, E);
    }
    SEAM(6);
    if (IN(7)) {
        pg8::PlainOrder S; S.init(hb, DFF, Wdn_a, DFF, args.out, D, 4, 256, T, D, G, bx);
        pg8::EpiF32Res E{D, (long)((const char*)x1 - (const char*)args.out), ALPHA};
        pg8::gemm_phase<pg8::EpiF32Res, pg8::PlainOrder, true, true>(lds, wave, DFF, DFF, DFF, S, E);
    }
    SEAM(7);
    if (IN(8)) ln_rows(args.out, args.in[10], args.in[11], x2, x2b, gw, NGW, lane);
    SEAM(8);
    if (IN(9)) {
        pg8::PlainOrder S; S.init(x2b, D, Win_b, D, proj1, D, 2, 256, T, D, G, bx);
        pg8::EpiBf16 E{D, 128 * D, 1.f};
        pg8::gemm_phase<pg8::EpiBf16, pg8::PlainOrder, true, true>(lds, wave, D, D, D, S, E);
    }
    SEAM(9);
    if (IN(10)) {
        const float* fg = args.in[13]; f32x4 g0 = *(const f32x4*)(fg + lane * 8), g1 = *(const f32x4*)(fg + lane * 8 + 4);
        for (int tok = gw; tok < T; tok += NGW) {
            const v4u raw = *(const v4u*)(proj1 + (size_t)tok * D + lane * 8); float v[8]; float s = 0.f;
#pragma unroll
            for (int j = 0; j < 4; ++j) { v[2 * j] = __uint_as_float(raw[j] << 16); v[2 * j + 1] = __uint_as_float(raw[j] & 0xffff0000u); s += v[2 * j] + v[2 * j + 1]; }
#pragma unroll
            for (int o = 1; o < 16; o <<= 1) s += __shfl_xor(s, o);
            const float mean = s * (1.f / 128.f); float q = 0.f;
#pragma unroll
            for (int j = 0; j < 8; ++j) { v[j] -= mean; q += v[j] * v[j]; }
#pragma unroll
            for (int o = 1; o < 16; o <<= 1) q += __shfl_xor(q, o);
            const float rstd = rsqrtf(q * (1.f / 128.f) + LN_EPS);
            v4u w; w.x = cvt_pk_bf16(v[0] * rstd * g0[0], v[1] * rstd * g0[1]); w.y = cvt_pk_bf16(v[2] * rstd * g0[2], v[3] * rstd * g0[3]);
            w.z = cvt_pk_bf16(v[4] * rstd * g1[0], v[5] * rstd * g1[1]); w.w = cvt_pk_bf16(v[6] * rstd * g1[2], v[7] * rstd * g1[3]);
            *(v4u*)(ub + (size_t)tok * 512 + lane * 8) = w;
        }
        __syncthreads();
        for (int p = 768 + bx; p < 1024; p += G) {
            const int hu = 2 * p + (wave >> 2);
            const att::HalfUnit u = make_half_unit(hu, proj1, D, 512, kv_b, og, lse, mix1, false);
            att::attn_pair((LAS char*)lds, wave, u);
        }
    }
    SEAM(10);
    if (IN(11)) {
        ChanOrder S{(const char*)TmE, (const char*)TmO, (const char*)ub, (char*)ACS, G, bx};
        pg8::EpiBf16 E{4096, 2048, 1.f};
        pg8::gemm_phase<pg8::EpiBf16, ChanOrder, true, true>(lds, wave, 256, 256, 512, S, E);
    }
    SEAM(11);
    if (IN(12)) {
        SeqOrder S{(const char*)CSm, (const char*)ACS, (char*)mix1, G, bx};
        pg8::EpiBf16 E{D, 128 * D, 1.f / 512.f};
        pg8::gemm_phase<pg8::EpiBf16, SeqOrder, true, true>(lds, wave, 4096, 4096, 4096, S, E);
        {
            constexpr int I_G = (D / 64) * (DFE / 64), NCHUNK = 24 * I_G / 8;
            for (;;) {
                unsigned ch = 0; if (lane == 0) ch = __hip_atomic_fetch_add(ctl + CW_CONV, 1u, __ATOMIC_RELAXED, __HIP_MEMORY_SCOPE_AGENT);
                ch = __builtin_amdgcn_readfirstlane(ch); if (ch >= (unsigned)NCHUNK) break;
#pragma unroll 1
                for (int it = (int)ch * 8; it < (int)ch * 8 + 8; ++it) { const int mtx = it / I_G, r = it - mtx * I_G, ex = mtx % 8, kind = mtx / 8;
                    if (kind == 0) conv_item<true>(args.in[20] + (size_t)ex * D * DFE, D, DFE, Wgu_m + (size_t)ex * 2 * DFE * D, 1, 0, 64.f, r, lane);
                    else if (kind == 1) conv_item<true>(args.in[21] + (size_t)ex * D * DFE, D, DFE, Wgu_m + (size_t)ex * 2 * DFE * D, 1, 128, 64.f, r, lane);
                    else conv_item<true>(args.in[22] + (size_t)ex * DFE * D, DFE, D, Wdn_m + (size_t)ex * D * DFE, 0, 0, 256.f, r, lane); }
            }
        }
    }
    SEAM(12);
    if (IN(13)) {
        pg8::PlainOrder S; S.init(mix1, D, Wout_b, D, args.out, D, 4, 256, T, D, G, bx);
        pg8::EpiF32Res E{D, (long)((const char*)x2 - (const char*)args.out), ALPHA};
        pg8::gemm_phase<pg8::EpiF32Res, pg8::PlainOrder, true, true>(lds, wave, D, D, D, S, E);
    }
    SEAM(13);
    if (IN(14)) {
        LAS float* rwl = (LAS float*)lds;
        LAS int* s_e = (LAS int*)(lds + 32768);
        LAS float* s_g = (LAS float*)(lds + 32768 + 512);
        { const float* rw = args.in[18];
#pragma unroll
          for (int j = 0; j < 4; ++j) *(LAS f32x4*)(rwl + (tid + 512 * j) * 4) = *(const f32x4*)(rw + (tid + 512 * j) * 4); }
        float rb[8];
#pragma unroll
        for (int e = 0; e < 8; ++e) rb[e] = args.in[19][e];
        f32x4 gv[4], bv[4];
#pragma unroll
        for (int j = 0; j < 4; ++j) { gv[j] = *(const f32x4*)(args.in[16] + 4 * lane + 256 * j); bv[j] = *(const f32x4*)(args.in[17] + 4 * lane + 256 * j); }
        __syncthreads();
        for (int chunk = bx; chunk < T / 64; chunk += G) {
#pragma unroll 1
            for (int i = 0; i < 8; ++i) {
                const int tok = chunk * 64 + wave * 8 + i;
                float* p = args.out + (size_t)tok * D + 4 * lane;
                f32x4 v[4]; float s = 0.f;
#pragma unroll
                for (int j = 0; j < 4; ++j) { v[j] = *(const f32x4*)(p + 256 * j); s += (v[j][0] + v[j][1]) + (v[j][2] + v[j][3]); }
                const float mean = wave_sum(s) * (1.f / D); float q = 0.f;
#pragma unroll
                for (int j = 0; j < 4; ++j) { v[j] = v[j] - mean; q += (v[j][0] * v[j][0] + v[j][1] * v[j][1]) + (v[j][2] * v[j][2] + v[j][3] * v[j][3]); }
                const float rstd = rsqrtf(wave_sum(q) * (1.f / D) + LN_EPS);
                float lg[8];
#pragma unroll
                for (int e = 0; e < 8; ++e) lg[e] = 0.f;
#pragma unroll
                for (int j = 0; j < 4; ++j) { const f32x4 o = v[j] * rstd * gv[j] + bv[j]; *(f32x4*)(p + 256 * j) = o;
#pragma unroll
                    for (int qd = 0; qd < 4; ++qd) { const LAS float* wr_ = rwl + (4 * lane + 256 * j + qd) * 8; const f32x4 wa = *(const LAS f32x4*)wr_, wb = *(const LAS f32x4*)(wr_ + 4);
                        lg[0] += o[qd] * wa[0]; lg[1] += o[qd] * wa[1]; lg[2] += o[qd] * wa[2]; lg[3] += o[qd] * wa[3]; lg[4] += o[qd] * wb[0]; lg[5] += o[qd] * wb[1]; lg[6] += o[qd] * wb[2]; lg[7] += o[qd] * wb[3]; } }
#pragma unroll
                for (int e = 0; e < 8; ++e) lg[e] = wave_sum(lg[e]) + rb[e];
                int e1 = 0; float v1 = lg[0];
#pragma unroll
                for (int e = 1; e < 8; ++e) if (lg[e] > v1) { v1 = lg[e]; e1 = e; }
                int e2 = 0; float v2 = -3.4e38f;
#pragma unroll
                for (int e = 0; e < 8; ++e) if (e != e1 && lg[e] > v2) { v2 = lg[e]; e2 = e; }
                const float p2 = __expf(v2 - v1), g1 = 1.f / (1.f + p2), g2 = p2 / (1.f + p2);
                if (lane == 0) { s_e[(wave * 8 + i) * 2] = e1; s_e[(wave * 8 + i) * 2 + 1] = e2; s_g[(wave * 8 + i) * 2] = g1; s_g[(wave * 8 + i) * 2 + 1] = g2; }
            }
            __syncthreads();
            if (wave == 0) {
                const int tok = chunk * 64 + lane; const int e1 = s_e[lane * 2], e2 = s_e[lane * 2 + 1];
                const unsigned long long ltm = (1ull << lane) - 1ull; unsigned pos1 = 0, pos2 = 0;
#pragma unroll
                for (int e = 0; e < 8; ++e) { const unsigned long long m1 = __ballot(e1 == e), m2 = __ballot(e2 == e); const unsigned c1 = __popcll(m1), c2 = __popcll(m2);
                    unsigned base = 0; if (lane == 0 && c1 + c2 > 0) base = __hip_atomic_fetch_add(cnt + e, c1 + c2, __ATOMIC_RELAXED, __HIP_MEMORY_SCOPE_AGENT);
                    base = __builtin_amdgcn_readfirstlane(base);
                    if (e1 == e) pos1 = base + __popcll(m1 & ltm);
                    if (e2 == e) pos2 = base + c1 + __popcll(m2 & ltm); }
                tslot[tok * 2] = ((unsigned)e1 << 20) | pos1; tslot[tok * 2 + 1] = ((unsigned)e2 << 20) | pos2;
                gates[tok * 2] = s_g[lane * 2]; gates[tok * 2 + 1] = s_g[lane * 2 + 1];
            }
            __syncthreads();
        }
    }
    SEAM(14);
    if (IN(15)) {
        unsigned pr[8]; { unsigned acc_ = 0;
#pragma unroll
            for (int e = 0; e < 8; ++e) { pr[e] = acc_; acc_ += ((__hip_atomic_load(cnt + e, __ATOMIC_RELAXED, __HIP_MEMORY_SCOPE_AGENT) + 255u) >> 8) << 8; } }
        for (int tok = gw; tok < T; tok += NGW) {
            const float* p = args.out + (size_t)tok * D + 16 * lane;
            v4u w;
#pragma unroll
            for (int j = 0; j < 4; ++j) { const f32x4 v = *(const f32x4*)(p + 4 * j); int q = 0; q = __builtin_amdgcn_cvt_pk_fp8_f32(v[0], v[1], q, false); q = __builtin_amdgcn_cvt_pk_fp8_f32(v[2], v[3], q, true); w[j] = (unsigned)q; }
#pragma unroll
            for (int k = 0; k < 2; ++k) { const unsigned ts = tslot[tok * 2 + k]; const unsigned e = ts >> 20, pos = ts & 0xfffffu; unsigned base = 0;
#pragma unroll
                for (int j = 0; j < 8; ++j) base = (e == (unsigned)j) ? pr[j] : base;
                const unsigned gs = base + pos;
                *(v4u*)(xs + (size_t)gs * D + 16 * lane) = w;
                if (lane == 0) tslot[tok * 2 + k] = gs; }
        }
    }
    SEAM(15);
    if (IN(16)) {
        MoeOrder S; S.init(cnt, xs, D / 2, Wgu_m, D / 2, 2 * DFE, Hm, DFE, 1, 128, 28, G, bx);
        pg8::EpiSwiGLU8 E{DFE, 1.f / 64.f};
        pg8::gemm_phase<pg8::EpiSwiGLU8, MoeOrder, true, true, true>(lds, wave, D / 2, D / 2, D / 2, S, E);
    }
    SEAM(16);
    if (IN(17)) {
        MoeOrder S; S.init(cnt, Hm, DFE / 2, Wdn_m, DFE / 2, D, Ym, D, 4, 256, 4, G, bx);
        pg8::EpiF32Scale E{D, 1.f / 256.f};
        pg8::gemm_phase<pg8::EpiF32Scale, MoeOrder, true, true, true>(lds, wave, DFE / 2, DFE / 2, DFE / 2, S, E);
    }
    SEAM(17);
    if (IN(18)) {
        f32x4 gv[4], bv[4];
#pragma unroll
        for (int j = 0; j < 4; ++j) { gv[j] = *(const f32x4*)(args.in[23] + 4 * lane + 256 * j); bv[j] = *(const f32x4*)(args.in[24] + 4 * lane + 256 * j); }
        for (int tok = gw; tok < T; tok += NGW) {
            float* p = args.out + (size_t)tok * D + 4 * lane;
            const unsigned s1 = tslot[tok * 2], s2 = tslot[tok * 2 + 1]; const float g1 = gates[tok * 2], g2 = gates[tok * 2 + 1];
            const float* y1 = Ym + (size_t)s1 * D + 4 * lane; const float* y2 = Ym + (size_t)s2 * D + 4 * lane;
            f32x4 v[4]; float s = 0.f;
#pragma unroll
            for (int j = 0; j < 4; ++j) { v[j] = *(const f32x4*)(p + 256 * j) * ALPHA + *(const f32x4*)(y1 + 256 * j) * g1 + *(const f32x4*)(y2 + 256 * j) * g2; s += (v[j][0] + v[j][1]) + (v[j][2] + v[j][3]); }
            const float mean = wave_sum(s) * (1.f / D); float q = 0.f;
#pragma unroll
            for (int j = 0; j < 4; ++j) { v[j] = v[j] - mean; q += (v[j][0] * v[j][0] + v[j][1] * v[j][1]) + (v[j][2] * v[j][2] + v[j][3] * v[j][3]); }
            const float rstd = rsqrtf(wave_sum(q) * (1.f / D) + LN_EPS);
#pragma unroll
            for (int j = 0; j < 4; ++j) *(f32x4*)(p + 256 * j) = v[j] * rstd * gv[j] + bv[j];
        }
    }
#undef IN
#undef SEAM
#undef lane
#undef tid
}
constexpr int N_PHASES = 19;

#ifndef MK_SINGLE
#define MK_SINGLE 1
#endif
extern "C" void kernel_launch(void* const* d_in, const int* in_sizes, int n_in, void* d_out, int out_size, void* d_ws, size_t ws_size, hipStream_t stream) {
    static int grid = 0;
    if (grid == 0) {
        if (n_in != 25 || out_size != T * D || ws_size < WS_NEED) { fprintf(stderr, "kernel_launch: unexpected shapes (n_in %d out %d ws %zu)\n", n_in, out_size, ws_size); grid = -1; return; }
        int dev = 0, cus = 0;
        if (hipGetDevice(&dev) != hipSuccess || hipDeviceGetAttribute(&cus, hipDeviceAttributeMultiprocessorCount, dev) != hipSuccess) { grid = -1; return; }
        if (hipFuncSetAttribute((const void*)mk_fwd, hipFuncAttributeMaxDynamicSharedMemorySize, LDS_BYTES) != hipSuccess) { fprintf(stderr, "kernel_launch: hipFuncSetAttribute failed\n"); grid = -1; return; }
        int per_cu = 0;
        if (hipOccupancyMaxActiveBlocksPerMultiprocessor(&per_cu, (const void*)mk_fwd, NWAVES * 64, LDS_BYTES) != hipSuccess || per_cu < 1) { fprintf(stderr, "kernel_launch: occupancy query says %d\n", per_cu); }
        (void)hipGetLastError();
        grid = cus;
    }
    if (grid < 0) return;
    float* out = (float*)d_out;
    char* ws = (char*)d_ws;
    (void)hipMemsetAsync(ws + WS_CTL, 0, CTL_ZERO_BYTES, stream);
    Args a{};
    for (int i = 0; i < 25; ++i) a.in[i] = (const float*)d_in[i];
    a.out = out; a.ws = (unsigned char*)d_ws;
    if (MK_SINGLE) { a.ph_lo = 0; a.ph_hi = N_PHASES; hipLaunchKernelGGL(mk_fwd, dim3(grid), dim3(NWAVES * 64), LDS_BYTES, stream, a); }
    else for (int ph = 0; ph < N_PHASES; ++ph) { a.ph_lo = ph; a.ph_hi = ph + 1; hipLaunchKernelGGL(mk_fwd, dim3(grid), dim3(NWAVES * 64), LDS_BYTES, stream, a); }
}
```
